# Optimizing an MI355X kernel written in HIP

```python
import jax, jax.numpy as jnp
from jax import lax
import numpy as np

D_MODEL = 1024
BATCH = 4
SEQ = 8192
DEPTH = 4

D_RNN = D_MODEL
RG_HEADS = 4
RG_BLOCK = D_RNN // RG_HEADS
RG_C = 8.0
CONV4_WIDTH = 4
D_CONV = D_MODEL
CONV3_WIDTH = 3
D_FF = ((8 * D_MODEL + 3 * 256 - 1) // (3 * 256)) * 256
PLE_DIM = 256
EPS = 1e-6
IN_SPLITS = (D_RNN, D_RNN, D_CONV, D_CONV, D_CONV, D_MODEL, D_MODEL)
W_IN = sum(IN_SPLITS)
IN_OFFSETS = tuple(int(v) for v in np.cumsum(IN_SPLITS)[:-1])

kernel_name = "hybrid_rglru_shortconv_block"


def rmsnorm(x, g):
    xf = x.astype(jnp.float32)
    y = xf * lax.rsqrt(jnp.mean(xf * xf, axis=-1, keepdims=True) + EPS)
    return (y * g.astype(jnp.float32)).astype(x.dtype)


def causal_depthwise_conv(x, w):
    k_w = w.shape[0]
    t = x.shape[1]
    xp = jnp.pad(x, ((0, 0), (k_w - 1, 0), (0, 0)))
    y = xp[:, 0:t] * w[0]
    for k in range(1, k_w):
        y = y + xp[:, k:k + t] * w[k]
    return y


def block_diag_linear(x, w, b):
    bsz, t, _ = x.shape
    xh = x.reshape(bsz, t, RG_HEADS, RG_BLOCK)
    y = jnp.einsum("bthi,hij->bthj", xh, w) + b
    return y.reshape(bsz, t, RG_HEADS * RG_BLOCK)


def rg_lru(x, w_r, b_r, w_i, b_i, lam):
    r = jax.nn.sigmoid(block_diag_linear(x, w_r, b_r).astype(jnp.float32))
    i = jax.nn.sigmoid(block_diag_linear(x, w_i, b_i).astype(jnp.float32))
    log_a = -RG_C * r * jax.nn.softplus(-lam.astype(jnp.float32))
    a = jnp.exp(log_a)
    mult = jnp.sqrt(-jnp.expm1(2.0 * log_a))
    u = mult * (i * x.astype(jnp.float32))

    def step(h, au):
        a_t, u_t = au
        h = a_t * h + u_t
        return h, h

    h0 = jnp.zeros((x.shape[0], x.shape[2]), jnp.float32)
    _, hs = lax.scan(step, h0, (jnp.swapaxes(a, 0, 1), jnp.swapaxes(u, 0, 1)))
    return jnp.swapaxes(hs, 0, 1).astype(x.dtype)


def hybrid_layer(x, p_i, g_mix, w_in, conv4_w, conv4_b, w_rg_r, b_rg_r, w_rg_i, b_rg_i,
                 lru_lambda, conv3_w, w_out, g_ffn, w_gate_up, w_down, g_ple, w_ple_gate, w_ple):
    h = rmsnorm(x, g_mix)
    z = h @ w_in
    rnn_x, rnn_y, conv_b, conv_c, conv_x, gate_rnn, gate_conv = jnp.split(z, IN_OFFSETS, axis=-1)
    rnn_x = causal_depthwise_conv(rnn_x, conv4_w) + conv4_b
    y_rnn = jax.nn.gelu(rnn_y) * rg_lru(rnn_x, w_rg_r, b_rg_r, w_rg_i, b_rg_i, lru_lambda)
    y_conv = conv_b * causal_depthwise_conv(conv_c * conv_x, conv3_w)
    merged = jax.nn.sigmoid(gate_rnn) * y_rnn + jax.nn.sigmoid(gate_conv) * y_conv
    x = x + merged @ w_out
    h = rmsnorm(x, g_ffn)
    g, u = jnp.split(h @ w_gate_up, 2, axis=-1)
    x = x + (jax.nn.silu(g) * u) @ w_down
    gate = jax.nn.sigmoid(rmsnorm(x, g_ple) @ w_ple_gate)
    x = x + gate * (p_i @ w_ple)
    return x


def setup_inputs(seed: int = 0) -> dict:
    key = jax.random.key(seed)
    ks = jax.random.split(key, 20)

    def nrm(k, shape, fan_in):
        return jax.random.normal(k, shape, jnp.float32) * (fan_in ** -0.5)

    def gain(k, shape):
        return 1.0 + 0.05 * jax.random.normal(k, shape, jnp.float32)

    def bias(k, shape):
        return 0.02 * jax.random.normal(k, shape, jnp.float32)

    x = jax.random.normal(ks[0], (BATCH, SEQ, D_MODEL), jnp.float32)
    p = jax.random.normal(ks[1], (DEPTH, BATCH, SEQ, PLE_DIM), jnp.float32)
    g_mix = gain(ks[2], (DEPTH, D_MODEL))
    w_in = nrm(ks[3], (DEPTH, D_MODEL, W_IN), D_MODEL)
    conv4_w = nrm(ks[4], (DEPTH, CONV4_WIDTH, D_RNN), CONV4_WIDTH)
    conv4_b = bias(ks[5], (DEPTH, D_RNN))
    w_rg_r = nrm(ks[6], (DEPTH, RG_HEADS, RG_BLOCK, RG_BLOCK), RG_BLOCK)
    b_rg_r = bias(ks[7], (DEPTH, RG_HEADS, RG_BLOCK))
    w_rg_i = nrm(ks[8], (DEPTH, RG_HEADS, RG_BLOCK, RG_BLOCK), RG_BLOCK)
    b_rg_i = bias(ks[9], (DEPTH, RG_HEADS, RG_BLOCK))
    a_c = jax.random.uniform(ks[10], (DEPTH, D_RNN), jnp.float32, minval=0.9, maxval=0.999)
    a0 = a_c ** (1.0 / RG_C)
    lru_lambda = jnp.log(a0) - jnp.log1p(-a0)
    conv3_w = nrm(ks[11], (DEPTH, CONV3_WIDTH, D_CONV), CONV3_WIDTH)
    w_out = nrm(ks[12], (DEPTH, D_MODEL, D_MODEL), D_MODEL)
    g_ffn = gain(ks[13], (DEPTH, D_MODEL))
    w_gate_up = nrm(ks[14], (DEPTH, D_MODEL, 2 * D_FF), D_MODEL)
    w_down = nrm(ks[15], (DEPTH, D_FF, D_MODEL), D_FF)
    g_ple = gain(ks[16], (DEPTH, D_MODEL))
    w_ple_gate = nrm(ks[17], (DEPTH, D_MODEL, D_MODEL), D_MODEL)
    w_ple = nrm(ks[18], (DEPTH, PLE_DIM, D_MODEL), PLE_DIM)
    g_final = gain(ks[19], (D_MODEL,))
    return {"x": x, "p": p, "g_mix": g_mix, "w_in": w_in, "conv4_w": conv4_w,
            "conv4_b": conv4_b, "w_rg_r": w_rg_r, "b_rg_r": b_rg_r, "w_rg_i": w_rg_i,
            "b_rg_i": b_rg_i, "lru_lambda": lru_lambda, "conv3_w": conv3_w, "w_out": w_out,
            "g_ffn": g_ffn, "w_gate_up": w_gate_up, "w_down": w_down, "g_ple": g_ple,
            "w_ple_gate": w_ple_gate, "w_ple": w_ple, "g_final": g_final}


def reference(x, p, g_mix, w_in, conv4_w, conv4_b, w_rg_r, b_rg_r, w_rg_i, b_rg_i,
              lru_lambda, conv3_w, w_out, g_ffn, w_gate_up, w_down, g_ple, w_ple_gate,
              w_ple, g_final):
    for i in range(DEPTH):
        x = hybrid_layer(x, p[i], g_mix[i], w_in[i], conv4_w[i], conv4_b[i], w_rg_r[i],
                         b_rg_r[i], w_rg_i[i], b_rg_i[i], lru_lambda[i], conv3_w[i], w_out[i],
                         g_ffn[i], w_gate_up[i], w_down[i], g_ple[i], w_ple_gate[i], w_ple[i])
    return rmsnorm(x, g_final)
```

```cpp
#include <hip/hip_runtime.h>
#include <hip/hip_cooperative_groups.h>
#include <cstdio>
#include <cstdint>
namespace cg = cooperative_groups;

#define LAS __attribute__((address_space(3)))
typedef unsigned short bf16_t;
typedef short bf16x8 __attribute__((ext_vector_type(8)));
typedef float f32x4 __attribute__((ext_vector_type(4)));
typedef float f32x2 __attribute__((ext_vector_type(2)));
typedef unsigned u32x4 __attribute__((ext_vector_type(4)));
typedef unsigned u32x2 __attribute__((ext_vector_type(2)));

constexpr int DM = 1024, BATCH = 4, SEQ = 8192, DEPTH = 4, M = BATCH * SEQ;
constexpr int DFF = 2816, WIN = 7168, PLE = 256;
constexpr int LCH = 64, NCHUNK = M / LCH;
constexpr float EPS = 1e-6f;

constexpr size_t MiB = 1u << 20;
constexpr size_t WS_SSQ1 = 0 * MiB, WS_SSQ2 = 2 * MiB, WS_SSQ3 = 4 * MiB, WS_PS = 6 * MiB, WS_HS = 8 * MiB, WS_CARRY = 10 * MiB, WS_SP8 = 12 * MiB;
constexpr size_t WS_BAR = 13 * MiB, BAR_BYTES = 16384;
constexpr size_t WS_WIN = 16 * MiB;
constexpr size_t WS_WG = 30 * MiB;
constexpr size_t WS_WOUT = 32 * MiB;
constexpr size_t WS_WGU = 34 * MiB;
constexpr size_t WS_WDN = 45 * MiB;
constexpr size_t WS_WPG = 51 * MiB;
constexpr size_t WS_WPLE = 53 * MiB;
constexpr size_t WS_PB = 56 * MiB;
constexpr size_t WS_XB = 72 * MiB;
constexpr size_t WS_RX = 136 * MiB;
constexpr size_t WS_CX = 200 * MiB;
constexpr size_t WS_GY = 264 * MiB;
constexpr size_t WS_GB = 328 * MiB;
constexpr size_t WS_XC = 392 * MiB;
constexpr size_t WS_U = 456 * MiB;
constexpr size_t WS_ACT = 136 * MiB;
constexpr size_t WS_END = 520 * MiB;
static_assert(WS_GY == WS_CX + 64 * MiB && WS_GB == WS_GY + 64 * MiB, "CX | GY | GB consecutive");

constexpr int NSUB = 9;
constexpr int RING_BYTES = 131072;
constexpr int SSQ_TAB_OFF = RING_BYTES + 1024;
constexpr int LDS_BYTES = SSQ_TAB_OFF + 16384 + 1024;

__device__ __forceinline__ unsigned cvt_pk_bf16(float lo, float hi) { unsigned r; asm volatile("v_cvt_pk_bf16_f32 %0, %1, %2" : "=v"(r) : "v"(lo), "v"(hi)); return r; }
__device__ __forceinline__ u32x4 pack8(const float (&f)[8]) { u32x4 w; w.x = cvt_pk_bf16(f[0], f[1]); w.y = cvt_pk_bf16(f[2], f[3]); w.z = cvt_pk_bf16(f[4], f[5]); w.w = cvt_pk_bf16(f[6], f[7]); return w; }
__device__ __forceinline__ void unpack8(const u32x4 w, float (&f)[8]) {
    f[0] = __uint_as_float(w.x << 16); f[1] = __uint_as_float(w.x & 0xffff0000u); f[2] = __uint_as_float(w.y << 16); f[3] = __uint_as_float(w.y & 0xffff0000u);
    f[4] = __uint_as_float(w.z << 16); f[5] = __uint_as_float(w.z & 0xffff0000u); f[6] = __uint_as_float(w.w << 16); f[7] = __uint_as_float(w.w & 0xffff0000u); }
__device__ __forceinline__ void unpack4(const u32x2 w, float (&f)[4]) {
    f[0] = __uint_as_float(w.x << 16); f[1] = __uint_as_float(w.x & 0xffff0000u); f[2] = __uint_as_float(w.y << 16); f[3] = __uint_as_float(w.y & 0xffff0000u); }
__device__ __forceinline__ float sigm(float v) { return __builtin_amdgcn_rcpf(1.f + __expf(-v)); }
__device__ __forceinline__ float gelu_tanh(float v) { return v * sigm(1.5957691216057308f * (v + 0.044715f * v * v * v)); }
__device__ __forceinline__ float row_rstd(const float* ssq, int row) {
    const f32x4* p = (const f32x4*)(ssq + (size_t)row * 16);
    const f32x4 a = p[0], b = p[1], c = p[2], d = p[3];
    const float s = (((a.x + a.y) + (a.z + a.w)) + ((b.x + b.y) + (b.z + b.w))) + (((c.x + c.y) + (c.z + c.w)) + ((d.x + d.y) + (d.z + d.w)));
    return rsqrtf(s * (1.0f / DM) + EPS);
}
__device__ __forceinline__ float row_rstd_q(const float* ssq, int row, int fq) {
    const f32x4 a = *(const f32x4*)(ssq + (size_t)row * 16 + fq * 4);
    float s = (a.x + a.y) + (a.z + a.w); s += __shfl_xor(s, 16); s += __shfl_xor(s, 32);
    return rsqrtf(s * (1.0f / DM) + EPS);
}
__device__ __forceinline__ f32x4 exp2n4(f32x4 x) {
    const f32x4 a = x * (-1.4426950408889634f); f32x4 e; e.x = __builtin_amdgcn_exp2f(a.x); e.y = __builtin_amdgcn_exp2f(a.y); e.z = __builtin_amdgcn_exp2f(a.z); e.w = __builtin_amdgcn_exp2f(a.w); return e; }
__device__ __forceinline__ f32x4 rcp4(f32x4 d) { f32x4 r; r.x = __builtin_amdgcn_rcpf(d.x); r.y = __builtin_amdgcn_rcpf(d.y); r.z = __builtin_amdgcn_rcpf(d.z); r.w = __builtin_amdgcn_rcpf(d.w); return r; }
__device__ __forceinline__ f32x4 sigm4(f32x4 x) { return rcp4(exp2n4(x) + 1.0f); }
__device__ __forceinline__ u32x2 pack4(f32x4 v) { u32x2 w; w.x = cvt_pk_bf16(v.x, v.y); w.y = cvt_pk_bf16(v.z, v.w); return w; }
__device__ __forceinline__ f32x4 unpack4v(const u32x2 w) { return (f32x4){__uint_as_float(w.x << 16), __uint_as_float(w.x & 0xffff0000u), __uint_as_float(w.y << 16), __uint_as_float(w.y & 0xffff0000u)}; }
__device__ __forceinline__ float row_rstd_lds(const LAS float* tab, int rl, int fq) {
    const f32x4 a = *(const LAS f32x4*)(tab + rl * 16 + fq * 4);
    float s = (a.x + a.y) + (a.z + a.w); s += __shfl_xor(s, 16); s += __shfl_xor(s, 32);
    return rsqrtf(s * (1.0f / DM) + EPS);
}
#define EPI_FENCE() asm volatile("" ::: "memory")
#define LDS_WAIT() asm volatile("s_waitcnt lgkmcnt(0)" ::: "memory")

namespace pg8 {
constexpr int BM = 256, BK = 64, HALF = 128, HTB = HALF * BK * 2, NXCD = 8, WGM = 8;
__host__ __device__ __forceinline__ int lds_byte(int r, int c) { const int st = (r >> 4) * 2 + (c >> 5), rr = r & 15, cc = c & 31, ob = rr * 64 + cc * 2; return st * 1024 + (ob ^ (((ob >> 9) & 1) << 5)); }
__host__ __device__ __forceinline__ void stage_rc(int b, int& R, int& C) { const int st = b / 1024, sb = b % 1024, swz = sb ^ (((sb >> 9) & 1) << 5); R = (st >> 1) * 16 + swz / 64; C = (st & 1) * 32 + (swz % 64) / 2; }
__host__ __device__ __forceinline__ int perm32(int rho) { const int n = rho >> 4, i = rho & 15; return 8 * (i >> 2) + 4 * n + (i & 3); }

struct Unit { int pm, pn; };
struct Gemm { const bf16_t* A; const bf16_t* Bt; };

struct StaticOrder {
    int nM, nN, nwg, G, c;
    __device__ void init(int M_, int N_, int G_, int c_) { nM = M_ / BM; nN = N_ / BM; nwg = nM * nN; G = G_; c = c_; }
    __device__ bool next(int i, Unit& u) const {
        const long L = (long)i * G + c; if (L >= nwg) return false;
        int wgid = (int)L; { const int q = nwg / NXCD, r = nwg % NXCD, xcd = wgid % NXCD, off = wgid / NXCD; wgid = (xcd < r ? xcd * (q + 1) : r * (q + 1) + (xcd - r) * q) + off; }
        const int nig = WGM * nN, gid = wgid / nig, fm = gid * WGM, gsz = (nM - fm) < WGM ? (nM - fm) : WGM;
        u.pm = fm + ((wgid % nig) % gsz); u.pn = (wgid % nig) / gsz; return true;
    }
};

typedef f32x4 Acc[2][2][4][2];

struct EpiWin {
    static constexpr bool PREF = true;
    bf16_t* RX; bf16_t* CX; const float* ssq; const LAS float* tab;
    __device__ __forceinline__ void operator()(const Acc& acc, const Unit& u, int wr, int wc, int fr, int fq) const {
        const int row0 = u.pm * BM + wr * 64 + fr;
        float rsv[2][4];
#pragma unroll
        for (int ai = 0; ai < 2; ++ai)
#pragma unroll
            for (int m = 0; m < 4; ++m) rsv[ai][m] = row_rstd_lds(tab, wr * 64 + fr + ai * HALF + m * 16, fq);
        EPI_FENCE();
        if (u.pn < 4) {
#pragma unroll
            for (int ai = 0; ai < 2; ++ai)
#pragma unroll
                for (int m = 0; m < 4; ++m) { const int row = row0 + ai * HALF + m * 16; const float rs = rsv[ai][m];
                    bf16_t* rp = RX + (size_t)row * DM + u.pn * BM + wc * 32 + 8 * fq;
#pragma unroll
                    for (int bj = 0; bj < 2; ++bj) { const u32x2 p0 = pack4(acc[ai][bj][m][0] * rs), p1 = pack4(acc[ai][bj][m][1] * rs);
                        *(u32x4*)(rp + bj * HALF) = (u32x4){p0.x, p0.y, p1.x, p1.y}; } EPI_FENCE(); }
        } else {
            const int q = (u.pn - 4) >> 3, j = (u.pn - 4) & 7;
            bf16_t* dst = CX + (size_t)q * (size_t)(32u << 20) + j * 128 + wc * 32 + 8 * fq;
#pragma unroll
            for (int ai = 0; ai < 2; ++ai)
#pragma unroll
                for (int m = 0; m < 4; ++m) { const int row = row0 + ai * HALF + m * 16; const float rs = rsv[ai][m];
                    u32x4 w;
#pragma unroll
                    for (int n = 0; n < 2; ++n) { const f32x4 v0 = acc[ai][0][m][n] * rs, v1 = acc[ai][1][m][n] * rs; f32x4 o;
                        if (q == 0) o = v0 * v1;
                        else if (q == 1) { const f32x4 t = (v0 * v0 * 0.044715f + 1.0f) * v0 * 1.5957691216057308f;
                            o = v0 * rcp4((exp2n4(t) + 1.0f) * (exp2n4(v1) + 1.0f)); }
                        else o = v0 * sigm4(v1);
                        const u32x2 p = pack4(o); if (n == 0) { w.x = p.x; w.y = p.y; } else { w.z = p.x; w.w = p.y; } }
                    *(u32x4*)(dst + (size_t)row * DM) = w; EPI_FENCE(); }
        }
    }
};
struct EpiGate {
    static constexpr bool PREF = false;
    bf16_t* PR; bf16_t* PI; const float* br; const float* bi;
    __device__ __forceinline__ void operator()(const Acc& acc, const Unit& u, int wr, int wc, int fr, int fq) const {
        const int row0 = u.pm * BM + wr * 64 + fr;
        const int c0 = (u.pn >> 1) * 256 + (u.pn & 1) * 128 + wc * 32 + 8 * fq;
        const f32x4 br0 = *(const f32x4*)(br + c0), br1 = *(const f32x4*)(br + c0 + 4), bi0 = *(const f32x4*)(bi + c0), bi1 = *(const f32x4*)(bi + c0 + 4);
#pragma unroll
        for (int ai = 0; ai < 2; ++ai)
#pragma unroll
            for (int m = 0; m < 4; ++m) { const int row = row0 + ai * HALF + m * 16; const unsigned off = (unsigned)row * DM + c0;
                const u32x2 r0 = pack4(acc[ai][0][m][0] + br0), r1 = pack4(acc[ai][0][m][1] + br1), i0 = pack4(acc[ai][1][m][0] + bi0), i1 = pack4(acc[ai][1][m][1] + bi1);
                *(u32x4*)(PR + off) = (u32x4){r0.x, r0.y, r1.x, r1.y}; *(u32x4*)(PI + off) = (u32x4){i0.x, i0.y, i1.x, i1.y}; EPI_FENCE(); }
    }
};
struct EpiRes {
    static constexpr bool PREF = false;
    const bf16_t* xin; bf16_t* xout; float* ssq;
    __device__ __forceinline__ void operator()(const Acc& acc, const Unit& u, int wr, int wc, int fr, int fq) const {
        const int row0 = u.pm * BM + wr * 64 + fr; const int col0 = u.pn * BM + wc * 32 + 8 * fq;
#pragma unroll
        for (int ai = 0; ai < 2; ++ai) {
            u32x4 xw[4][2];
#pragma unroll
            for (int m = 0; m < 4; ++m)
#pragma unroll
                for (int bj = 0; bj < 2; ++bj) xw[m][bj] = *(const u32x4*)(xin + (unsigned)(row0 + ai * HALF + m * 16) * DM + col0 + bj * HALF);
            EPI_FENCE();
#pragma unroll
            for (int m = 0; m < 4; ++m) { const int row = row0 + ai * HALF + m * 16; float ss = 0.f;
#pragma unroll
                for (int bj = 0; bj < 2; ++bj) { const unsigned off = (unsigned)row * DM + col0 + bj * HALF;
                    const f32x4 v0 = unpack4v((u32x2){xw[m][bj].x, xw[m][bj].y}) + acc[ai][bj][m][0], v1 = unpack4v((u32x2){xw[m][bj].z, xw[m][bj].w}) + acc[ai][bj][m][1];
                    const f32x4 q = v0 * v0 + v1 * v1; ss += (q.x + q.y) + (q.z + q.w);
                    const u32x2 p0 = pack4(v0), p1 = pack4(v1); *(u32x4*)(xout + off) = (u32x4){p0.x, p0.y, p1.x, p1.y}; }
                ss += __shfl_xor(ss, 16); ss += __shfl_xor(ss, 32);
                if (fq == 0) ssq[(size_t)row * 16 + u.pn * 4 + wc] = ss; }
            EPI_FENCE();
        }
    }
};
struct EpiPle {
    static constexpr bool PREF = true;
    const bf16_t* xin; bf16_t* xout; const bf16_t* E; const float* ssq; float* ssq_out; const LAS float* tab;
    __device__ __forceinline__ void operator()(const Acc& acc, const Unit& u, int wr, int wc, int fr, int fq) const {
        const int row0 = u.pm * BM + wr * 64 + fr; const int col0 = u.pn * BM + wc * 32 + 8 * fq;
        float rsv[2][4];
#pragma unroll
        for (int ai = 0; ai < 2; ++ai)
#pragma unroll
            for (int m = 0; m < 4; ++m) rsv[ai][m] = row_rstd_lds(tab, wr * 64 + fr + ai * HALF + m * 16, fq);
        EPI_FENCE();
#pragma unroll
        for (int ai = 0; ai < 2; ++ai)
#pragma unroll
            for (int mh = 0; mh < 4; mh += 2) {
                u32x4 xw[2][2], ew[2][2];
#pragma unroll
                for (int m = 0; m < 2; ++m)
#pragma unroll
                    for (int bj = 0; bj < 2; ++bj) { const unsigned off = (unsigned)(row0 + ai * HALF + (mh + m) * 16) * DM + col0 + bj * HALF; xw[m][bj] = *(const u32x4*)(xin + off); ew[m][bj] = *(const u32x4*)(E + off); }
                EPI_FENCE();
#pragma unroll
                for (int m = 0; m < 2; ++m) { const int row = row0 + ai * HALF + (mh + m) * 16; const float rs = rsv[ai][mh + m]; float ss = 0.f;
#pragma unroll
                    for (int bj = 0; bj < 2; ++bj) { const unsigned off = (unsigned)row * DM + col0 + bj * HALF;
                        const f32x4 v0 = unpack4v((u32x2){xw[m][bj].x, xw[m][bj].y}) + sigm4(acc[ai][bj][mh + m][0] * rs) * unpack4v((u32x2){ew[m][bj].x, ew[m][bj].y});
                        const f32x4 v1 = unpack4v((u32x2){xw[m][bj].z, xw[m][bj].w}) + sigm4(acc[ai][bj][mh + m][1] * rs) * unpack4v((u32x2){ew[m][bj].z, ew[m][bj].w});
                        const f32x4 q = v0 * v0 + v1 * v1; ss += (q.x + q.y) + (q.z + q.w);
                        const u32x2 p0 = pack4(v0), p1 = pack4(v1); *(u32x4*)(xout + off) = (u32x4){p0.x, p0.y, p1.x, p1.y}; }
                    ss += __shfl_xor(ss, 16); ss += __shfl_xor(ss, 32);
                    if (fq == 0) ssq_out[(size_t)row * 16 + u.pn * 4 + wc] = ss; }
                EPI_FENCE();
            }
    }
};
struct EpiSwi {
    static constexpr bool PREF = true;
    bf16_t* ACT; const float* ssq; const LAS float* tab;
    __device__ __forceinline__ void operator()(const Acc& acc, const Unit& u, int wr, int wc, int fr, int fq) const {
        const int row0 = u.pm * BM + wr * 64 + fr; const int col0 = u.pn * 128 + wc * 32 + 8 * fq;
        float rsv[2][4];
#pragma unroll
        for (int ai = 0; ai < 2; ++ai)
#pragma unroll
            for (int m = 0; m < 4; ++m) rsv[ai][m] = row_rstd_lds(tab, wr * 64 + fr + ai * HALF + m * 16, fq);
        EPI_FENCE();
#pragma unroll
        for (int ai = 0; ai < 2; ++ai)
#pragma unroll
            for (int m = 0; m < 4; ++m) { const int row = row0 + ai * HALF + m * 16; const float rs = rsv[ai][m];
                const f32x4 g0 = acc[ai][0][m][0] * rs, g1 = acc[ai][0][m][1] * rs;
                const u32x2 p0 = pack4(g0 * sigm4(g0) * (acc[ai][1][m][0] * rs)), p1 = pack4(g1 * sigm4(g1) * (acc[ai][1][m][1] * rs));
                *(u32x4*)(ACT + (size_t)row * DFF + col0) = (u32x4){p0.x, p0.y, p1.x, p1.y}; EPI_FENCE(); }
    }
};
struct EpiBf {
    static constexpr bool PREF = false;
    bf16_t* O; int ldc;
    __device__ __forceinline__ void operator()(const Acc& acc, const Unit& u, int wr, int wc, int fr, int fq) const {
        const int row0 = u.pm * BM + wr * 64 + fr; const int col0 = u.pn * BM + wc * 32 + 8 * fq;
#pragma unroll
        for (int ai = 0; ai < 2; ++ai)
#pragma unroll
            for (int m = 0; m < 4; ++m) { const int row = row0 + ai * HALF + m * 16;
#pragma unroll
                for (int bj = 0; bj < 2; ++bj) { float v[8];
#pragma unroll
                    for (int e = 0; e < 8; ++e) v[e] = acc[ai][bj][m][e >> 2][e & 3];
                    *(u32x4*)(O + (size_t)row * ldc + col0 + bj * HALF) = pack8(v); } EPI_FENCE(); }
    }
};

template <int K, int LDA, int LDB, int ACS, int KREP = 1, class Epi>
__device__ __forceinline__ void gemm_phase(LAS unsigned char* lds, const int tid, const Gemm g, const StaticOrder& S, const Epi& E) {
    const int wid = __builtin_amdgcn_readfirstlane(tid >> 6), lane = tid & 63, wr = wid >> 2, wc = wid & 3, fr = lane & 15, fq = lane >> 4;
    constexpr int nt = K / BK;
    unsigned voffA[2], voffB[2];
#pragma unroll
    for (int i = 0; i < 2; ++i) { int R, C; stage_rc(tid * 16 + i * 8192, R, C); const int Rb = (R & ~31) + perm32(R & 31);
        voffA[i] = (unsigned)(R * LDA + C) * 2u; voffB[i] = (unsigned)(Rb * LDB + C) * 2u; }
    constexpr size_t kstep = (size_t)(BK * 2);
    constexpr size_t hstepA = (size_t)HALF * LDA * 2, hstepB = (size_t)HALF * LDB * 2;
    constexpr size_t tstepA = 2 * hstepA, tstepB = 2 * hstepB;
    const unsigned ldsw = (unsigned)wid * 1024u;
    const int aoff = lds_byte(wr * 64 + fr, fq * 8), boff = lds_byte(wc * 32 + fr, fq * 8);
#define PG8_SA(b, h) (((b) * 2 + (h)) * HTB)
#define PG8_SB(b, h) ((4 + (b) * 2 + (h)) * HTB)
#define PG8_STAGE(bufoff, gbase, voff) do { _Pragma("unroll") for (int _i = 0; _i < 2; ++_i) \
        __builtin_amdgcn_global_load_lds((const unsigned*)((const char*)(gbase) + (voff)[_i]), (LAS unsigned*)(lds + (bufoff) + ldsw + _i * 8192), 16, 0, 0); } while (0)
#define PG8_LDA(dst, b, h) do { _Pragma("unroll") for (int m = 0; m < 4; ++m) _Pragma("unroll") for (int k = 0; k < 2; ++k) dst[m][k] = *(const LAS bf16x8*)(lds + PG8_SA(b, h) + aoff + m * 2048 + k * 1024); } while (0)
#define PG8_LDB(dst, b, h) do { _Pragma("unroll") for (int n = 0; n < 2; ++n) _Pragma("unroll") for (int k = 0; k < 2; ++k) dst[n][k] = *(const LAS bf16x8*)(lds + PG8_SB(b, h) + boff + n * 2048 + k * 1024); } while (0)
#define PG8_MMA(ai, bj, At, Bt) do { __builtin_amdgcn_s_setprio(1); _Pragma("unroll") for (int m = 0; m < 4; ++m) _Pragma("unroll") for (int n = 0; n < 2; ++n) _Pragma("unroll") for (int k = 0; k < 2; ++k) \
        acc[ai][bj][m][n] = __builtin_amdgcn_mfma_f32_16x16x32_bf16(Bt[n][k], At[m][k], acc[ai][bj][m][n], 0, 0, 0); __builtin_amdgcn_s_setprio(0); } while (0)
#define PG8_WAIT_V(n) asm volatile("s_waitcnt vmcnt(" #n ")" ::: "memory")
#define PG8_WAIT_L(n) asm volatile("s_waitcnt lgkmcnt(" #n ")" ::: "memory")
#define PG8_BAR __builtin_amdgcn_s_barrier()
#define PG8_SCHED __builtin_amdgcn_sched_barrier(0)
    Unit cur, nxt; int ui = 0;
    if (!S.next(0, cur)) return;
    Acc acc;
#pragma unroll
    for (int a = 0; a < 2; ++a)
#pragma unroll
        for (int b = 0; b < 2; ++b)
#pragma unroll
            for (int m = 0; m < 4; ++m)
#pragma unroll
                for (int n = 0; n < 2; ++n) acc[a][b][m][n] = (f32x4){0.f, 0.f, 0.f, 0.f};
    bf16x8 At[4][2], B0[2][2], B1[2][2];
    const char* cA = (const char*)g.A + (size_t)cur.pm * tstepA + (size_t)((cur.pn >> 1) * ACS) * 2; const char* cB = (const char*)g.Bt + (size_t)cur.pn * tstepB;
    PG8_STAGE(PG8_SB(0, 0), cB, voffB); PG8_STAGE(PG8_SB(0, 1), cB + hstepB, voffB); PG8_STAGE(PG8_SA(0, 0), cA, voffA); PG8_STAGE(PG8_SA(0, 1), cA + hstepA, voffA);
    if (wr == 1) PG8_BAR;
    PG8_WAIT_V(2); PG8_BAR;
    PG8_STAGE(PG8_SB(1, 0), cB + kstep, voffB); PG8_STAGE(PG8_SA(1, 0), cA + kstep, voffA); PG8_STAGE(PG8_SB(1, 1), cB + hstepB + kstep, voffB);
    PG8_WAIT_V(6); PG8_BAR;
    for (;;) {
        const bool has_next = S.next(ui + 1, nxt);
        const char* nA = has_next ? (const char*)g.A + (size_t)nxt.pm * tstepA + (size_t)((nxt.pn >> 1) * ACS) * 2 : cA; const char* nB = has_next ? (const char*)g.Bt + (size_t)nxt.pn * tstepB : cB;
#pragma unroll 1
        for (int tt = 0; tt < nt * KREP; tt += 2) {
            const int t = (KREP == 1) ? tt : tt % nt;
            const bool last = (t == nt - 2), lastrep = (KREP == 1) || (tt == nt * KREP - 2);
            const char* a1 = cA + (size_t)(t + 1) * kstep;
            const char* a2 = last ? (lastrep ? nA : cA) : cA + (size_t)(t + 2) * kstep; const char* b2 = last ? (lastrep ? nB : cB) : cB + (size_t)(t + 2) * kstep;
            const char* a3 = a2 + kstep; const char* b3 = b2 + kstep;
            PG8_LDB(B0, 0, 0); PG8_LDB(B1, 0, 1); PG8_SCHED; PG8_LDA(At, 0, 0); PG8_STAGE(PG8_SA(1, 1), a1 + hstepA, voffA);
            PG8_WAIT_V(8); PG8_WAIT_L(0); PG8_BAR; PG8_MMA(0, 0, At, B0); PG8_MMA(0, 1, At, B1); PG8_BAR; PG8_SCHED;
            if constexpr (Epi::PREF) { if (tt == 0) {
#pragma unroll
                for (int q_ = 0; q_ < 2; ++q_) { const int p_ = 2 * wc + q_, rl_ = (p_ >> 2) * HALF + wr * 64 + (p_ & 3) * 16;
                    __builtin_amdgcn_global_load_lds((const unsigned*)(E.ssq + ((size_t)cur.pm * BM + rl_) * 16 + lane * 4), (LAS unsigned*)(lds + SSQ_TAB_OFF + rl_ * 64), 16, 0, 0); } }
                PG8_SCHED; }
            PG8_LDA(At, 0, 1); PG8_STAGE(PG8_SB(0, 0), b2, voffB); PG8_STAGE(PG8_SB(0, 1), b2 + hstepB, voffB); PG8_STAGE(PG8_SA(0, 0), a2, voffA);
            PG8_WAIT_V(8); PG8_WAIT_L(0); PG8_BAR; PG8_MMA(1, 0, At, B0); PG8_MMA(1, 1, At, B1); PG8_BAR; PG8_SCHED;
            PG8_LDB(B0, 1, 0); PG8_LDB(B1, 1, 1); PG8_SCHED; PG8_LDA(At, 1, 0); PG8_STAGE(PG8_SA(0, 1), a2 + hstepA, voffA);
            PG8_WAIT_V(8); PG8_WAIT_L(0); PG8_BAR; PG8_MMA(0, 0, At, B0); PG8_MMA(0, 1, At, B1); PG8_BAR; PG8_SCHED;
            PG8_LDA(At, 1, 1); PG8_STAGE(PG8_SB(1, 0), b3, voffB); PG8_STAGE(PG8_SB(1, 1), b3 + hstepB, voffB); PG8_STAGE(PG8_SA(1, 0), a3, voffA);
            PG8_WAIT_V(8); PG8_WAIT_L(0); PG8_BAR; PG8_MMA(1, 0, At, B0); PG8_MMA(1, 1, At, B1); PG8_BAR; PG8_SCHED;
        }
        if (wr == 0) PG8_BAR;
        if constexpr (KREP != 1) {
#pragma unroll
            for (int a = 0; a < 2; ++a)
#pragma unroll
                for (int b = 0; b < 2; ++b)
#pragma unroll
                    for (int m = 0; m < 4; ++m)
#pragma unroll
                        for (int n = 0; n < 2; ++n) acc[a][b][m][n] = acc[a][b][m][n] * (1.0f / KREP);
        }
        E(acc, cur, wr, wc, fr, fq);
        if (!has_next) break;
#pragma unroll
        for (int a = 0; a < 2; ++a)
#pragma unroll
            for (int b = 0; b < 2; ++b)
#pragma unroll
                for (int m = 0; m < 4; ++m)
#pragma unroll
                    for (int n = 0; n < 2; ++n) acc[a][b][m][n] = (f32x4){0.f, 0.f, 0.f, 0.f};
        cur = nxt; cA = nA; cB = nB; ++ui;
        if (wr == 1) PG8_BAR;
    }
    PG8_WAIT_V(0);
    PG8_BAR;
#undef PG8_SA
#undef PG8_SB
#undef PG8_STAGE
#undef PG8_LDA
#undef PG8_LDB
#undef PG8_MMA
#undef PG8_WAIT_V
#undef PG8_WAIT_L
#undef PG8_BAR
#undef PG8_SCHED
}
}

__device__ __forceinline__ void wconv_item(const float* src, int ldsrc, const float* gain, bf16_t* dst, int lddst, LAS float* scr, int lane) {
    float wv[32];
#pragma unroll
    for (int i = 0; i < 32; ++i) { const int kk = 2 * i + (lane >> 5); wv[i] = src[(size_t)kk * ldsrc + (lane & 31)]; }
    if (gain) {
#pragma unroll
        for (int i = 0; i < 32; ++i) wv[i] *= gain[2 * i + (lane >> 5)]; }
#pragma unroll
    for (int i = 0; i < 32; ++i) { const int kk = 2 * i + (lane >> 5); scr[kk * 33 + (lane & 31)] = wv[i]; }
    LDS_WAIT(); asm volatile("" ::: "memory");
    const int c = lane & 7;
#pragma unroll
    for (int j = 0; j < 4; ++j) { const int n = (lane >> 3) + 8 * j; const LAS float* s = scr + (8 * c) * 33 + n;
        u32x4 o; o.x = cvt_pk_bf16(s[0 * 33], s[1 * 33]); o.y = cvt_pk_bf16(s[2 * 33], s[3 * 33]); o.z = cvt_pk_bf16(s[4 * 33], s[5 * 33]); o.w = cvt_pk_bf16(s[6 * 33], s[7 * 33]);
        *(u32x4*)(dst + (size_t)n * lddst + 8 * c) = o; }
    LDS_WAIT(); asm volatile("" ::: "memory");
}
__device__ __forceinline__ int win_src_col(int n0) {
    const int pn = n0 >> 8, rr = n0 & 255;
    if (pn < 4) return n0;
    const int q = (pn - 4) >> 3, j = (pn - 4) & 7, half = rr >> 7, off = rr & 127;
    int base;
    if (q == 0) base = half ? 4096 : 3072;
    else if (q == 1) base = half ? 5120 : 1024;
    else base = half ? 6144 : 2048;
    return base + 128 * j + off;
}


#define XB_TMO      128
#define XB_XCNT(j)  (256  + 64 * (j))
#define XB_XSUB(j)  (1280 + 64 * (j))
#define XB_XGEN(j)  (2304 + 64 * (j))
#define XB_TOP      3328
#define XB_TOPGEN   3392
#define XCD_BAR_WORDS 3456
#define XB_SPIN_CAP (1u << 18)
__device__ __forceinline__ unsigned xb_ld(unsigned* p)              { return __hip_atomic_load(p, __ATOMIC_RELAXED, __HIP_MEMORY_SCOPE_AGENT); }
__device__ __forceinline__ unsigned xb_add(unsigned* p, unsigned v) { return __hip_atomic_fetch_add(p, v, __ATOMIC_RELAXED, __HIP_MEMORY_SCOPE_AGENT); }
__device__ __forceinline__ unsigned xb_xcc_id() { return (unsigned)__builtin_amdgcn_s_getreg((3 << 11) | 20) & 0xFu; }
#define XB_SPIN(cond, bar) do { unsigned _sp = 0; while (cond) { __builtin_amdgcn_s_sleep(1); \
    if ((++_sp & 255u) == 0u) { if (xb_ld(&(bar)[XB_TMO])) break; if (_sp > XB_SPIN_CAP) { atomicAdd(&(bar)[XB_TMO], 1u); break; } } } } while (0)
struct XcdBarrier { unsigned* bar; unsigned x; volatile LAS unsigned* st; };
__device__ __forceinline__ XcdBarrier xcd_barrier_post(unsigned* bar, volatile LAS unsigned* st) {
    XcdBarrier b; b.bar = bar; b.x = xb_xcc_id(); b.st = st;
    if (threadIdx.x == 0) (void)xb_add(&bar[XB_XCNT(b.x)], 1u);
    return b;
}
__device__ __forceinline__ void xcd_barrier_complete(unsigned* bar, unsigned x, unsigned& nloc, unsigned& nx) {
    const unsigned G = gridDim.x * gridDim.y * gridDim.z;
    unsigned sum, cnt, mine, sp = 0u;
    for (;;) {
        sum = 0u; cnt = 0u; mine = 0u;
#pragma unroll
        for (unsigned j = 0; j < 16; ++j) { const unsigned c = xb_ld(&bar[XB_XCNT(j)]); sum += c; cnt += (c > 0u) ? 1u : 0u; mine = (j == x) ? c : mine; }
        if (sum == G) break;
        __builtin_amdgcn_s_sleep(1);
        if ((++sp & 255u) == 0u) { if (xb_ld(&bar[XB_TMO])) break; if (sp > XB_SPIN_CAP) { atomicAdd(&bar[XB_TMO], 1u); break; } }
    }
    nloc = mine > 0u ? mine : 1u; nx = cnt > 0u ? cnt : 1u;
}
__device__ __forceinline__ void xcd_barrier(const XcdBarrier& b) {
    asm volatile("s_waitcnt vmcnt(0)" ::: "memory");
    __syncthreads();
    if (threadIdx.x == 0) {
        unsigned* bar = b.bar;
        __builtin_amdgcn_s_waitcnt(0);
        unsigned nloc = b.st[0], nx = b.st[1];
        if (nloc == 0u) { xcd_barrier_complete(bar, b.x, nloc, nx); b.st[0] = nloc; b.st[1] = nx; }
        const unsigned old = xb_add(&bar[XB_XSUB(b.x)], 1u);
        const unsigned gen = old / nloc;
        if (old + 1u == (gen + 1u) * nloc) {
            __builtin_amdgcn_fence(__ATOMIC_RELEASE, "agent");
            asm volatile("s_waitcnt vmcnt(0)" ::: "memory");
            const unsigned og = xb_add(&bar[XB_TOP], 1u);
            const unsigned tg = og / nx;
            if (og + 1u == (tg + 1u) * nx) xb_add(&bar[XB_TOPGEN], 1u);
            else XB_SPIN(xb_ld(&bar[XB_TOPGEN]) == tg, bar);
            __builtin_amdgcn_fence(__ATOMIC_ACQUIRE, "agent");
            xb_add(&bar[XB_XGEN(b.x)], 1u);
            asm volatile("s_waitcnt vmcnt(0)" ::: "memory");
        } else {
            XB_SPIN(xb_ld(&bar[XB_XGEN(b.x)]) == gen, bar);
            __builtin_amdgcn_fence(__ATOMIC_ACQUIRE, "agent");
            asm volatile("s_waitcnt vmcnt(0)" ::: "memory");
        }
    }
    __syncthreads();
}

struct Args { const float* in[20]; float* out; unsigned char* ws; int ph_lo, ph_hi; };

struct Ctx {
    const float* const* in; unsigned char* ws; float* X; LAS unsigned char* lds;
    int tid, lane, wave, gtid, NT, gw, NGW, G;
};

__device__ __forceinline__ void conv_early(const Ctx& c, int l) {
    LAS float* scr = (LAS float*)(c.lds + c.wave * 16384);
    bf16_t* WINT = (bf16_t*)(c.ws + WS_WIN); bf16_t* WGT = (bf16_t*)(c.ws + WS_WG);
    const float* w_in = c.in[3] + (size_t)l * DM * WIN; const float* g_mix = c.in[2] + l * DM;
    const float* wr_ = c.in[6] + (size_t)l * 262144; const float* wi_ = c.in[8] + (size_t)l * 262144;
    constexpr int I_WIN = 16 * 224, I_G = 4 * 64;
    for (int it = c.gw; it < I_WIN + I_G; it += c.NGW) {
        if (it < I_WIN) { const int kb = it / 224, nb = it % 224, k0 = 64 * kb, n0 = 32 * nb;
            wconv_item(w_in + (size_t)k0 * WIN + win_src_col(n0), WIN, g_mix + k0, WINT + (size_t)n0 * DM + k0, DM, scr, c.lane); }
        else { const int r = it - I_WIN, kb = r / 64, nb = r % 64, k0 = 64 * kb, n0 = 32 * nb;
            const int h = n0 >> 9, jt = (n0 >> 8) & 1, half = (n0 >> 7) & 1, off = n0 & 127;
            const float* src = (half ? wi_ : wr_) + (size_t)h * 65536 + (size_t)k0 * 256 + 128 * jt + off;
            wconv_item(src, 256, nullptr, WGT + (size_t)n0 * 256 + k0, 256, scr, c.lane); }
    }
}
__device__ __forceinline__ void conv_late(const Ctx& c, int l) {
    LAS float* scr = (LAS float*)(c.lds + c.wave * 16384);
    bf16_t* WOUT = (bf16_t*)(c.ws + WS_WOUT); bf16_t* WGU = (bf16_t*)(c.ws + WS_WGU); bf16_t* WDN = (bf16_t*)(c.ws + WS_WDN); bf16_t* WPG = (bf16_t*)(c.ws + WS_WPG); bf16_t* WPLE = (bf16_t*)(c.ws + WS_WPLE);
    const float* w_out = c.in[12] + (size_t)l * DM * DM; const float* g_ffn = c.in[13] + l * DM; const float* w_gu = c.in[14] + (size_t)l * DM * 2 * DFF;
    const float* w_dn = c.in[15] + (size_t)l * DFF * DM; const float* g_ple = c.in[16] + l * DM; const float* w_pg = c.in[17] + (size_t)l * DM * DM; const float* w_ple = c.in[18] + (size_t)l * PLE * DM;
    constexpr int I_O = 16 * 32, I_GU = 16 * 176, I_DN = 44 * 32, I_PG = 16 * 32, I_PL = 4 * 32;
    for (int it = c.gw; it < I_O + I_GU + I_DN + I_PG + I_PL; it += c.NGW) {
        int r = it;
        if (r < I_O) { const int kb = r / 32, nb = r % 32, k0 = 64 * kb, n0 = 32 * nb; wconv_item(w_out + (size_t)k0 * DM + n0, DM, nullptr, WOUT + (size_t)n0 * DM + k0, DM, scr, c.lane); continue; } r -= I_O;
        if (r < I_GU) { const int kb = r / 176, nb = r % 176, k0 = 64 * kb, n0 = 32 * nb; const int pn = n0 >> 8, half = (n0 >> 7) & 1, off = n0 & 127;
            wconv_item(w_gu + (size_t)k0 * (2 * DFF) + half * DFF + 128 * pn + off, 2 * DFF, g_ffn + k0, WGU + (size_t)n0 * DM + k0, DM, scr, c.lane); continue; } r -= I_GU;
        if (r < I_DN) { const int kb = r / 32, nb = r % 32, k0 = 64 * kb, n0 = 32 * nb; wconv_item(w_dn + (size_t)k0 * DM + n0, DM, nullptr, WDN + (size_t)n0 * DFF + k0, DFF, scr, c.lane); continue; } r -= I_DN;
        if (r < I_PG) { const int kb = r / 32, nb = r % 32, k0 = 64 * kb, n0 = 32 * nb; wconv_item(w_pg + (size_t)k0 * DM + n0, DM, g_ple + k0, WPG + (size_t)n0 * DM + k0, DM, scr, c.lane); continue; } r -= I_PG;
        { const int kb = r / 32, nb = r % 32, k0 = 64 * kb, n0 = 32 * nb; wconv_item(w_ple + (size_t)k0 * DM + n0, DM, nullptr, WPLE + (size_t)n0 * PLE + k0, PLE, scr, c.lane); }
    }
    const float* p = c.in[1] + (size_t)l * M * PLE; bf16_t* PB = (bf16_t*)(c.ws + WS_PB);
    for (int it0 = c.gtid; it0 < M * PLE / 8; it0 += 4 * c.NT) {
        f32x4 a[4], b[4];
#pragma unroll
        for (int q = 0; q < 4; ++q) { const int it = it0 + q * c.NT; if (it < M * PLE / 8) { a[q] = *(const f32x4*)(p + (size_t)it * 8); b[q] = *(const f32x4*)(p + (size_t)it * 8 + 4); } }
#pragma unroll
        for (int q = 0; q < 4; ++q) { const int it = it0 + q * c.NT; if (it < M * PLE / 8) {
            u32x4 w; w.x = cvt_pk_bf16(a[q].x, a[q].y); w.y = cvt_pk_bf16(a[q].z, a[q].w); w.z = cvt_pk_bf16(b[q].x, b[q].y); w.w = cvt_pk_bf16(b[q].z, b[q].w); *(u32x4*)(PB + (size_t)it * 8) = w; } }
    }
}

__device__ __forceinline__ float wave_sum(float v) {
#pragma unroll
    for (int o = 1; o < 64; o <<= 1) v += __shfl_xor(v, o);
    return v;
}

__device__ __forceinline__ void prologue(const Ctx& c) {
    const float* x = c.in[0]; bf16_t* XB = (bf16_t*)c.X; float* ssq1 = (float*)(c.ws + WS_SSQ1);
    for (int m0 = c.gw * 4; m0 < M; m0 += c.NGW * 4) {
        f32x4 v[4][4];
#pragma unroll
        for (int r = 0; r < 4; ++r) { const f32x4* xr = (const f32x4*)(x + (size_t)(m0 + r) * DM) + c.lane;
#pragma unroll
            for (int j = 0; j < 4; ++j) v[r][j] = xr[64 * j]; }
#pragma unroll
        for (int r = 0; r < 4; ++r) { const int m = m0 + r; float s = 0.f;
#pragma unroll
            for (int j = 0; j < 4; ++j) s += (v[r][j].x * v[r][j].x + v[r][j].y * v[r][j].y) + (v[r][j].z * v[r][j].z + v[r][j].w * v[r][j].w);
            s = wave_sum(s);
            u32x2* o = (u32x2*)(XB + (size_t)m * DM) + c.lane;
#pragma unroll
            for (int j = 0; j < 4; ++j) { u32x2 w; w.x = cvt_pk_bf16(v[r][j].x, v[r][j].y); w.y = cvt_pk_bf16(v[r][j].z, v[r][j].w); o[64 * j] = w; }
            if (c.lane < 16) ssq1[(size_t)m * 16 + c.lane] = (c.lane == 0) ? s : 0.f; }
    }
    float* sp8 = (float*)(c.ws + WS_SP8); const float* lam = c.in[10];
    for (int i = c.gtid; i < DEPTH * DM; i += c.NT) sp8[i] = 8.0f * log1pf(expf(-lam[i]));
    conv_early(c, 0);
}

__device__ __forceinline__ void conv4_phase(const Ctx& c, int l) {
    const bf16_t* RX = (const bf16_t*)(c.ws + WS_RX); bf16_t* XC = (bf16_t*)(c.ws + WS_XC);
    const float* w4 = c.in[4] + (size_t)l * 4 * DM; const float* b4 = c.in[5] + l * DM;
    for (int item = c.gtid; item < (M / 8) * 128; item += c.NT) {
        const int run = item >> 7, c0 = (item & 127) * 8, t0 = run * 8;
        float w[4][8], b[8];
#pragma unroll
        for (int k = 0; k < 4; ++k) { const f32x4 a = *(const f32x4*)(w4 + k * DM + c0), bb = *(const f32x4*)(w4 + k * DM + c0 + 4);
            w[k][0] = a.x; w[k][1] = a.y; w[k][2] = a.z; w[k][3] = a.w; w[k][4] = bb.x; w[k][5] = bb.y; w[k][6] = bb.z; w[k][7] = bb.w; }
        { const f32x4 a = *(const f32x4*)(b4 + c0), bb = *(const f32x4*)(b4 + c0 + 4); b[0] = a.x; b[1] = a.y; b[2] = a.z; b[3] = a.w; b[4] = bb.x; b[5] = bb.y; b[6] = bb.z; b[7] = bb.w; }
        float h0[8], h1[8], h2[8];
        if ((t0 & (SEQ - 1)) == 0) {
#pragma unroll
            for (int e = 0; e < 8; ++e) { h0[e] = 0.f; h1[e] = 0.f; h2[e] = 0.f; }
        } else {
            unpack8(*(const u32x4*)(RX + (size_t)(t0 - 3) * DM + c0), h0); unpack8(*(const u32x4*)(RX + (size_t)(t0 - 2) * DM + c0), h1); unpack8(*(const u32x4*)(RX + (size_t)(t0 - 1) * DM + c0), h2);
        }
        u32x4 wrow[8];
#pragma unroll
        for (int i = 0; i < 8; ++i) wrow[i] = *(const u32x4*)(RX + (size_t)(t0 + i) * DM + c0);
#pragma unroll
        for (int i = 0; i < 8; ++i) { float f[8], o[8]; unpack8(wrow[i], f);
#pragma unroll
            for (int e = 0; e < 8; ++e) { o[e] = b[e] + w[0][e] * h0[e] + w[1][e] * h1[e] + w[2][e] * h2[e] + w[3][e] * f[e]; h0[e] = h1[e]; h1[e] = h2[e]; h2[e] = f[e]; }
            *(u32x4*)(XC + (size_t)(t0 + i) * DM + c0) = pack8(o); }
    }
}

__device__ __forceinline__ f32x4 gate_em4(f32x4 x2) {
    f32x4 em = x2 * (x2 * (x2 * (x2 * (x2 * (x2 * 0.0013888889f + 0.0083333338f) + 0.041666668f) + 0.16666667f) + 0.5f) + 1.0f);
    if (__builtin_amdgcn_ballot_w64((x2.x <= -0.25f) | (x2.y <= -0.25f) | (x2.z <= -0.25f) | (x2.w <= -0.25f)) != 0ull) {
#pragma unroll
        for (int e = 0; e < 4; ++e) if (x2[e] <= -0.25f) em[e] = __expf(x2[e]) - 1.f; }
    return em;
}
__device__ __forceinline__ void gate_step4(f32x4 pr, f32x4 pi, f32x4 xc, f32x4 sp, f32x4& hl, f32x4& cp) {
    const f32x4 r = sigm4(pr), ig = sigm4(pi);
    const f32x4 lg = -(r * sp), em = gate_em4(lg + lg);
    f32x4 s; s.x = __builtin_amdgcn_sqrtf(-em.x); s.y = __builtin_amdgcn_sqrtf(-em.y); s.z = __builtin_amdgcn_sqrtf(-em.z); s.w = __builtin_amdgcn_sqrtf(-em.w);
    const f32x4 a = exp2n4(-lg);
    hl = a * hl + s * ig * xc; cp = cp * a;
}
__device__ __forceinline__ void scan_local(const Ctx& c, int l) {
    bf16_t* PR = (bf16_t*)(c.ws + WS_RX); bf16_t* PI = (bf16_t*)(c.ws + WS_U); const bf16_t* XC = (const bf16_t*)(c.ws + WS_XC);
    float* PS = (float*)(c.ws + WS_PS); float* HS = (float*)(c.ws + WS_HS); const float* sp8 = (const float*)(c.ws + WS_SP8) + l * DM;
    if (c.tid >= 256) return;
    for (int item = (c.gtid >> 9) * 256 + c.tid; item < NCHUNK * 128; item += c.G * 256) {
        const int chunk = item >> 7, c0 = (item & 127) * 8;
        const f32x4 sp0 = *(const f32x4*)(sp8 + c0), sp1 = *(const f32x4*)(sp8 + c0 + 4);
        f32x4 hl0 = (f32x4){0.f, 0.f, 0.f, 0.f}, hl1 = hl0, cp0 = (f32x4){1.f, 1.f, 1.f, 1.f}, cp1 = cp0;
        const size_t base = (size_t)chunk * LCH * DM + c0;
        u32x4 nr_[4], ni_[4], nx_[4];
#pragma unroll
        for (int j = 0; j < 4; ++j) { const size_t o = base + (size_t)j * DM; nr_[j] = *(const u32x4*)(PR + o); ni_[j] = *(const u32x4*)(PI + o); nx_[j] = *(const u32x4*)(XC + o); }
#pragma unroll 1
        for (int tb = 0; tb < LCH; tb += 4) {
            u32x4 wr_[4], wi_[4], wx_[4];
#pragma unroll
            for (int j = 0; j < 4; ++j) { wr_[j] = nr_[j]; wi_[j] = ni_[j]; wx_[j] = nx_[j]; }
            if (tb + 4 < LCH) {
#pragma unroll
                for (int j = 0; j < 4; ++j) { const size_t o = base + (size_t)(tb + 4 + j) * DM; nr_[j] = *(const u32x4*)(PR + o); ni_[j] = *(const u32x4*)(PI + o); nx_[j] = *(const u32x4*)(XC + o); } }
#pragma unroll
            for (int j = 0; j < 4; ++j) {
                gate_step4(unpack4v((u32x2){wr_[j].x, wr_[j].y}), unpack4v((u32x2){wi_[j].x, wi_[j].y}), unpack4v((u32x2){wx_[j].x, wx_[j].y}), sp0, hl0, cp0);
                gate_step4(unpack4v((u32x2){wr_[j].z, wr_[j].w}), unpack4v((u32x2){wi_[j].z, wi_[j].w}), unpack4v((u32x2){wx_[j].z, wx_[j].w}), sp1, hl1, cp1);
                const size_t o = base + (size_t)(tb + j) * DM;
                const u32x2 h0 = pack4(hl0), h1 = pack4(hl1), q0 = pack4(cp0), q1 = pack4(cp1);
                *(u32x4*)(PI + o) = (u32x4){h0.x, h0.y, h1.x, h1.y}; *(u32x4*)(PR + o) = (u32x4){q0.x, q0.y, q1.x, q1.y}; }
        }
        *(f32x4*)(PS + (size_t)chunk * DM + c0) = cp0; *(f32x4*)(PS + (size_t)chunk * DM + c0 + 4) = cp1;
        *(f32x4*)(HS + (size_t)chunk * DM + c0) = hl0; *(f32x4*)(HS + (size_t)chunk * DM + c0 + 4) = hl1;
    }
}
__device__ __forceinline__ void merge_phase(const Ctx& c, int l, unsigned bx) {
    const bf16_t* CP = (const bf16_t*)(c.ws + WS_RX); const bf16_t* HL = (const bf16_t*)(c.ws + WS_U); const bf16_t* CX = (const bf16_t*)(c.ws + WS_CX);
    const bf16_t* GY = (const bf16_t*)(c.ws + WS_GY); const bf16_t* GB = (const bf16_t*)(c.ws + WS_GB); bf16_t* MG = (bf16_t*)(c.ws + WS_XC);
    const float* PS = (const float*)(c.ws + WS_PS); const float* HS = (const float*)(c.ws + WS_HS); const float* w3 = c.in[11] + (size_t)l * 3 * DM;
    LAS float* carr = (LAS float*)c.lds;
    constexpr int CPS = SEQ / LCH;
    for (int rb = (int)bx; rb < M / 128; rb += c.G) {
        const int k0 = 2 * rb, kk0 = k0 % CPS, kbase = k0 - kk0;
        { const int c2 = 2 * c.tid; f32x2 carry = (f32x2){0.f, 0.f};
#pragma unroll 1
          for (int k = 0; k < kk0; k += 16) {
              f32x2 P[16], H[16];
#pragma unroll
              for (int j = 0; j < 16; ++j) { const int kc = (k + j < kk0) ? (k + j) : (kk0 - 1); P[j] = *(const f32x2*)(PS + (size_t)(kbase + kc) * DM + c2); H[j] = *(const f32x2*)(HS + (size_t)(kbase + kc) * DM + c2); }
#pragma unroll
              for (int j = 0; j < 16; ++j) { if (k + j < kk0) carry = P[j] * carry + H[j]; } }
          const f32x2 P = *(const f32x2*)(PS + (size_t)k0 * DM + c2), H = *(const f32x2*)(HS + (size_t)k0 * DM + c2);
          const f32x2 carry1 = P * carry + H;
          carr[c2] = carry.x; carr[c2 + 1] = carry.y; carr[DM + c2] = carry1.x; carr[DM + c2 + 1] = carry1.y; }
        __syncthreads();
#pragma unroll 1
        for (int it = 0; it < 4; ++it) {
            const int item = c.tid + 512 * it, run = item >> 7, c0 = (item & 127) * 8, t0 = rb * 128 + run * 8;
            float w[3][8], cr[8];
#pragma unroll
            for (int k = 0; k < 3; ++k) { const f32x4 a = *(const f32x4*)(w3 + k * DM + c0), bb = *(const f32x4*)(w3 + k * DM + c0 + 4);
                w[k][0] = a.x; w[k][1] = a.y; w[k][2] = a.z; w[k][3] = a.w; w[k][4] = bb.x; w[k][5] = bb.y; w[k][6] = bb.z; w[k][7] = bb.w; }
            { const LAS f32x4* cp4 = (const LAS f32x4*)(carr + (run >> 3) * DM + c0); const f32x4 a = cp4[0], bb = cp4[1]; cr[0] = a.x; cr[1] = a.y; cr[2] = a.z; cr[3] = a.w; cr[4] = bb.x; cr[5] = bb.y; cr[6] = bb.z; cr[7] = bb.w; }
            float p0[8], p1[8];
            if ((t0 & (SEQ - 1)) == 0) {
#pragma unroll
                for (int e = 0; e < 8; ++e) { p0[e] = 0.f; p1[e] = 0.f; }
            } else { unpack8(*(const u32x4*)(CX + (size_t)(t0 - 2) * DM + c0), p0); unpack8(*(const u32x4*)(CX + (size_t)(t0 - 1) * DM + c0), p1); }
#pragma unroll
            for (int ib = 0; ib < 8; ib += 4) {
                u32x4 whl[4], wcp[4], wgy[4], wgb[4], wcx[4];
#pragma unroll
                for (int i = 0; i < 4; ++i) { const size_t off = (size_t)(t0 + ib + i) * DM + c0;
                    whl[i] = *(const u32x4*)(HL + off); wcp[i] = *(const u32x4*)(CP + off); wgy[i] = *(const u32x4*)(GY + off); wgb[i] = *(const u32x4*)(GB + off); wcx[i] = *(const u32x4*)(CX + off); }
#pragma unroll
                for (int i = 0; i < 4; ++i) { const size_t off = (size_t)(t0 + ib + i) * DM + c0;
                    float hl[8], cp[8], gy[8], gb[8], cx[8], o[8];
                    unpack8(whl[i], hl); unpack8(wcp[i], cp); unpack8(wgy[i], gy); unpack8(wgb[i], gb); unpack8(wcx[i], cx);
#pragma unroll
                    for (int e = 0; e < 8; ++e) { const float h = hl[e] + cp[e] * cr[e]; o[e] = gy[e] * h + gb[e] * (w[0][e] * p0[e] + w[1][e] * p1[e] + w[2][e] * cx[e]); p0[e] = p1[e]; p1[e] = cx[e]; }
                    *(u32x4*)(MG + off) = pack8(o); }
            }
        }
        __syncthreads();
    }
}
__device__ __forceinline__ void final_phase(const Ctx& c) {
    const float* ssq = (const float*)(c.ws + WS_SSQ1); const float* g = c.in[19]; const bf16_t* xl = (const bf16_t*)(c.ws + WS_XC);
    f32x4 gv[4];
#pragma unroll
    for (int j = 0; j < 4; ++j) gv[j] = ((const f32x4*)g)[c.lane + 64 * j];
    for (int m0 = c.gw * 4; m0 < M; m0 += c.NGW * 4) {
        u32x2 xw[4][4]; float rs[4];
#pragma unroll
        for (int r = 0; r < 4; ++r) { const u32x2* xr = (const u32x2*)(xl + (size_t)(m0 + r) * DM) + c.lane; rs[r] = row_rstd(ssq, m0 + r);
#pragma unroll
            for (int j = 0; j < 4; ++j) xw[r][j] = xr[64 * j]; }
#pragma unroll
        for (int r = 0; r < 4; ++r) { f32x4* orow = (f32x4*)((float*)c.X + (size_t)(m0 + r) * DM) + c.lane;
#pragma unroll
            for (int j = 0; j < 4; ++j) orow[64 * j] = unpack4v(xw[r][j]) * rs[r] * gv[j]; }
    }
}

__global__ void __launch_bounds__(512, 2) fwd_mega(Args a) {
    extern __shared__ __attribute__((aligned(16))) unsigned char lds_raw[];
    cg::grid_group grid = cg::this_grid();
    volatile LAS unsigned* bst = (volatile LAS unsigned*)((LAS unsigned char*)lds_raw + RING_BYTES + 256);
    if (threadIdx.x < 8) bst[threadIdx.x] = 0u;
    __syncthreads();
    const XcdBarrier xbar = xcd_barrier_post((unsigned*)(a.ws + WS_BAR), bst);
    unsigned* xcnt = (unsigned*)(a.ws + WS_BAR) + 3584;
    if (threadIdx.x == 0) bst[4] = xb_add(&xcnt[64 * xbar.x], 1u);
    __syncthreads();
    const unsigned my_rank = (unsigned)__builtin_amdgcn_readfirstlane((int)bst[4]);
    unsigned vcu = blockIdx.x; bool vcu_known = false;
#ifndef KREP_WIN
#define KREP_WIN 1
#endif
#ifndef DUPMASK
#define DUPMASK 0
#endif
#ifndef EXTRA_SYNCS
#define EXTRA_SYNCS 0
#endif
    bool dup_done = false;
    for (int ph = a.ph_lo; ph < a.ph_hi; ++ph) {
        if (!vcu_known && ph > a.ph_lo) {
            bool ok = (gridDim.x % 8u) == 0u;
            for (unsigned j = 0; j < 8; ++j) ok = ok && ((unsigned)__builtin_amdgcn_readfirstlane((int)xb_ld(&xcnt[64 * j])) == gridDim.x / 8u);
            if (ok && xbar.x < 8u && my_rank < gridDim.x / 8u) vcu = my_rank * 8u + xbar.x;
            vcu_known = true;
        }
        int tid_ = threadIdx.x; unsigned bx_ = vcu; size_t zoff_ = 0;
        asm volatile("" : "+v"(tid_)); asm volatile("" : "+s"(bx_)); asm volatile("" : "+s"(zoff_));
        unsigned char* ws = a.ws + zoff_; float* outp = a.out + zoff_;
        Ctx c;
        c.in = a.in; c.ws = ws; c.X = outp; c.lds = (LAS unsigned char*)lds_raw;
        c.tid = tid_; c.lane = c.tid & 63; c.wave = __builtin_amdgcn_readfirstlane(c.tid >> 6);
        c.G = gridDim.x; c.gtid = bx_ * 512 + c.tid; c.NT = c.G * 512; c.gw = bx_ * 8 + c.wave; c.NGW = c.G * 8;
        bf16_t* XB = (bf16_t*)(ws + WS_XB);
        bf16_t* XBA = (bf16_t*)outp;
        float* ssq1 = (float*)(ws + WS_SSQ1); float* ssq2 = (float*)(ws + WS_SSQ2); float* ssq3 = (float*)(ws + WS_SSQ3);
        if (ph == 0) prologue(c);
        else if (ph == 1 + NSUB * DEPTH) final_phase(c);
        else {
            const int l = (ph - 1) / NSUB, s = (ph - 1) % NSUB;
            pg8::StaticOrder S;
            switch (s) {
#if !defined(ONLY) || ONLY == 0
            case 0: {
                pg8::Gemm g{XBA, (const bf16_t*)(ws + WS_WIN)}; S.init(M, WIN, c.G, bx_);
                pg8::EpiWin E{(bf16_t*)(ws + WS_RX), (bf16_t*)(ws + WS_CX), ssq1, (const LAS float*)(c.lds + SSQ_TAB_OFF)};
                pg8::gemm_phase<DM, DM, DM, 0, KREP_WIN>(c.lds, c.tid, g, S, E); } break;
#endif
#if !defined(ONLY) || ONLY == 1
            case 1: conv4_phase(c, l); conv_late(c, l); break;
#endif
#if !defined(ONLY) || ONLY == 2
            case 2: {
                pg8::Gemm g{(const bf16_t*)(ws + WS_XC), (const bf16_t*)(ws + WS_WG)}; S.init(M, 2048, c.G, bx_);
                pg8::EpiGate E{(bf16_t*)(ws + WS_RX), (bf16_t*)(ws + WS_U), a.in[7] + l * DM, a.in[9] + l * DM};
                pg8::gemm_phase<256, DM, 256, 256>(c.lds, c.tid, g, S, E); } break;
#endif
#if !defined(ONLY) || ONLY == 3
            case 3: scan_local(c, l); if (l + 1 < DEPTH) conv_early(c, l + 1); break;
#endif
#if !defined(ONLY) || ONLY == 5
            case 4: merge_phase(c, l, bx_); break;
#endif
#if !defined(ONLY) || ONLY == 6
            case 5: {
                { pg8::Gemm g{(const bf16_t*)(ws + WS_XC), (const bf16_t*)(ws + WS_WOUT)}; S.init(M, DM, c.G, bx_);
                  pg8::EpiRes E{XBA, XB, ssq2};
                  pg8::gemm_phase<DM, DM, DM, 0>(c.lds, c.tid, g, S, E); }
                { int tid2 = c.tid; asm volatile("" : "+v"(tid2));
                  pg8::Gemm g{(const bf16_t*)(ws + WS_PB), (const bf16_t*)(ws + WS_WPLE)}; S.init(M, DM, c.G, bx_);
                  pg8::EpiBf E{(bf16_t*)(ws + WS_U), DM};
                  pg8::gemm_phase<PLE, PLE, PLE, 0>(c.lds, tid2, g, S, E); } } break;
#endif
#if !defined(ONLY) || ONLY == 7
            case 6: {
                pg8::Gemm g{XB, (const bf16_t*)(ws + WS_WGU)}; S.init(M, 2 * DFF, c.G, bx_);
                pg8::EpiSwi E{(bf16_t*)(ws + WS_ACT), ssq2, (const LAS float*)(c.lds + SSQ_TAB_OFF)};
                pg8::gemm_phase<DM, DM, DM, 0>(c.lds, c.tid, g, S, E); } break;
#endif
#if !defined(ONLY) || ONLY == 8
            case 7: {
                pg8::Gemm g{(const bf16_t*)(ws + WS_ACT), (const bf16_t*)(ws + WS_WDN)}; S.init(M, DM, c.G, bx_);
                pg8::EpiRes E{XB, XB, ssq3};
                pg8::gemm_phase<DFF, DFF, DFF, 0>(c.lds, c.tid, g, S, E); } break;
#endif
#if !defined(ONLY) || ONLY == 9
            default: {
                pg8::Gemm g{XB, (const bf16_t*)(ws + WS_WPG)}; S.init(M, DM, c.G, bx_);
                pg8::EpiPle E{XB, (l == DEPTH - 1) ? (bf16_t*)(ws + WS_XC) : XBA, (const bf16_t*)(ws + WS_U), ssq3, ssq1, (const LAS float*)(c.lds + SSQ_TAB_OFF)};
                pg8::gemm_phase<DM, DM, DM, 0>(c.lds, c.tid, g, S, E); } break;
#endif
            }
        }
        if (ph + 1 < a.ph_hi) { if (a.ph_hi < 0) grid.sync(); else xcd_barrier(xbar); }
        for (int xs = 0; xs < EXTRA_SYNCS; ++xs) xcd_barrier(xbar);
        if (DUPMASK != 0 && ph >= 1 && ph <= NSUB * DEPTH && ((DUPMASK >> ((ph - 1) % NSUB)) & 1) && !dup_done) { dup_done = true; --ph; } else dup_done = false;
    }
}

extern "C" void kernel_launch(void* const* d_in, const int* in_sizes, int n_in, void* d_out, int out_size, void* d_ws, size_t ws_size, hipStream_t stream) {
    static int grid = 0;
    if (grid == 0) {
        if (n_in != 20 || out_size != M * DM || ws_size < WS_END) { fprintf(stderr, "kernel_launch: unexpected sizes n_in %d out %d ws %zu\n", n_in, out_size, ws_size); grid = -1; return; }
        int dev = 0, cus = 0, per_cu = 0;
        hipGetDevice(&dev); hipDeviceGetAttribute(&cus, hipDeviceAttributeMultiprocessorCount, dev);
        if (hipFuncSetAttribute((const void*)fwd_mega, hipFuncAttributeMaxDynamicSharedMemorySize, LDS_BYTES) != hipSuccess) { fprintf(stderr, "kernel_launch: hipFuncSetAttribute failed\n"); grid = -1; return; }
        if (hipOccupancyMaxActiveBlocksPerMultiprocessor(&per_cu, (const void*)fwd_mega, 512, LDS_BYTES) != hipSuccess || per_cu < 1) { fprintf(stderr, "kernel_launch: occupancy query gives %d\n", per_cu); per_cu = 1; }
        (void)hipGetLastError();
        grid = cus * 1;
    }
    if (grid < 0) return;
    if (hipMemsetAsync((char*)d_ws + WS_BAR, 0, BAR_BYTES, stream) != hipSuccess) { fprintf(stderr, "kernel_launch: memset failed\n"); return; }
    Args a{};
    for (int i = 0; i < 20; ++i) a.in[i] = (const float*)d_in[i];
    a.out = (float*)d_out; a.ws = (unsigned char*)d_ws; a.ph_lo = 0; a.ph_hi = 2 + NSUB * DEPTH;
    void* args[] = {&a};
    hipError_t e = hipLaunchCooperativeKernel((const void*)fwd_mega, dim3(grid), dim3(512), args, LDS_BYTES, stream);
    if (e != hipSuccess) fprintf(stderr, "cooperative launch failed: %s (grid %d)\n", hipGetErrorString(e), grid);
}
```

```cpp
#include <hip/hip_runtime.h>
#include <hip/hip_cooperative_groups.h>
#include <cstdio>
#include <cstdint>
namespace cg = cooperative_groups;

#define LAS __attribute__((address_space(3)))
typedef unsigned short bf16_t;
typedef short bf16x8 __attribute__((ext_vector_type(8)));
typedef float f32x4 __attribute__((ext_vector_type(4)));
typedef float f32x2 __attribute__((ext_vector_type(2)));
typedef unsigned u32x4 __attribute__((ext_vector_type(4)));
typedef unsigned u32x2 __attribute__((ext_vector_type(2)));

constexpr int DM = 1024, BATCH = 4, SEQ = 8192, DEPTH = 4, M = BATCH * SEQ;
constexpr int DFF = 2816, WIN = 7168, PLE = 256;
constexpr int LCH = 64, NCHUNK = M / LCH;
constexpr float EPS = 1e-6f;

constexpr size_t MiB = 1u << 20;
constexpr size_t WS_SSQ1 = 0 * MiB, WS_SSQ2 = 2 * MiB, WS_SSQ3 = 4 * MiB, WS_PS = 6 * MiB, WS_HS = 8 * MiB, WS_CARRY = 10 * MiB, WS_SP8 = 12 * MiB;
constexpr size_t WS_BAR = 13 * MiB, BAR_BYTES = 16384;
constexpr size_t WS_WIN = 16 * MiB;
constexpr size_t WS_WG = 30 * MiB;
constexpr size_t WS_WOUT = 32 * MiB;
constexpr size_t WS_WGU = 34 * MiB;
constexpr size_t WS_WDN = 45 * MiB;
constexpr size_t WS_WPG = 51 * MiB;
constexpr size_t WS_WPLE = 53 * MiB;
constexpr size_t WS_PB = 56 * MiB;
constexpr size_t WS_XB = 72 * MiB;
constexpr size_t WS_RX = 136 * MiB;
constexpr size_t WS_CX = 200 * MiB;
constexpr size_t WS_GY = 264 * MiB;
constexpr size_t WS_GB = 328 * MiB;
constexpr size_t WS_XC = 392 * MiB;
constexpr size_t WS_U = 456 * MiB;
constexpr size_t WS_ACT = 136 * MiB;
constexpr size_t WS_END = 520 * MiB;
static_assert(WS_GY == WS_CX + 64 * MiB && WS_GB == WS_GY + 64 * MiB, "CX | GY | GB consecutive");

constexpr int NSUB = 9;
constexpr int RING_BYTES = 131072;
constexpr int SSQ_TAB_OFF = RING_BYTES + 1024;
constexpr int LDS_BYTES = SSQ_TAB_OFF + 16384 + 1024;

__device__ __forceinline__ unsigned cvt_pk_bf16(float lo, float hi) { unsigned r; asm volatile("v_cvt_pk_bf16_f32 %0, %1, %2" : "=v"(r) : "v"(lo), "v"(hi)); return r; }
__device__ __forceinline__ u32x4 pack8(const float (&f)[8]) { u32x4 w; w.x = cvt_pk_bf16(f[0], f[1]); w.y = cvt_pk_bf16(f[2], f[3]); w.z = cvt_pk_bf16(f[4], f[5]); w.w = cvt_pk_bf16(f[6], f[7]); return w; }
__device__ __forceinline__ void unpack8(const u32x4 w, float (&f)[8]) {
    f[0] = __uint_as_float(w.x << 16); f[1] = __uint_as_float(w.x & 0xffff0000u); f[2] = __uint_as_float(w.y << 16); f[3] = __uint_as_float(w.y & 0xffff0000u);
    f[4] = __uint_as_float(w.z << 16); f[5] = __uint_as_float(w.z & 0xffff0000u); f[6] = __uint_as_float(w.w << 16); f[7] = __uint_as_float(w.w & 0xffff0000u); }
__device__ __forceinline__ void unpack4(const u32x2 w, float (&f)[4]) {
    f[0] = __uint_as_float(w.x << 16); f[1] = __uint_as_float(w.x & 0xffff0000u); f[2] = __uint_as_float(w.y << 16); f[3] = __uint_as_float(w.y & 0xffff0000u); }
__device__ __forceinline__ float sigm(float v) { return __builtin_amdgcn_rcpf(1.f + __expf(-v)); }
__device__ __forceinline__ float gelu_tanh(float v) { return v * sigm(1.5957691216057308f * (v + 0.044715f * v * v * v)); }
__device__ __forceinline__ float row_rstd(const float* ssq, int row) {
    const f32x4* p = (const f32x4*)(ssq + (size_t)row * 16);
    const f32x4 a = p[0], b = p[1], c = p[2], d = p[3];
    const float s = (((a.x + a.y) + (a.z + a.w)) + ((b.x + b.y) + (b.z + b.w))) + (((c.x + c.y) + (c.z + c.w)) + ((d.x + d.y) + (d.z + d.w)));
    return rsqrtf(s * (1.0f / DM) + EPS);
}
__device__ __forceinline__ float row_rstd_q(const float* ssq, int row, int fq) {
    const f32x4 a = *(const f32x4*)(ssq + (size_t)row * 16 + fq * 4);
    float s = (a.x + a.y) + (a.z + a.w); s += __shfl_xor(s, 16); s += __shfl_xor(s, 32);
    return rsqrtf(s * (1.0f / DM) + EPS);
}
__device__ __forceinline__ f32x4 exp2n4(f32x4 x) {
    const f32x4 a = x * (-1.4426950408889634f); f32x4 e; e.x = __builtin_amdgcn_exp2f(a.x); e.y = __builtin_amdgcn_exp2f(a.y); e.z = __builtin_amdgcn_exp2f(a.z); e.w = __builtin_amdgcn_exp2f(a.w); return e; }
__device__ __forceinline__ f32x4 rcp4(f32x4 d) { f32x4 r; r.x = __builtin_amdgcn_rcpf(d.x); r.y = __builtin_amdgcn_rcpf(d.y); r.z = __builtin_amdgcn_rcpf(d.z); r.w = __builtin_amdgcn_rcpf(d.w); return r; }
__device__ __forceinline__ f32x4 sigm4(f32x4 x) { return rcp4(exp2n4(x) + 1.0f); }
__device__ __forceinline__ u32x2 pack4(f32x4 v) { u32x2 w; w.x = cvt_pk_bf16(v.x, v.y); w.y = cvt_pk_bf16(v.z, v.w); return w; }
__device__ __forceinline__ f32x4 unpack4v(const u32x2 w) { return (f32x4){__uint_as_float(w.x << 16), __uint_as_float(w.x & 0xffff0000u), __uint_as_float(w.y << 16), __uint_as_float(w.y & 0xffff0000u)}; }
__device__ __forceinline__ float row_rstd_lds(const LAS float* tab, int rl, int fq) {
    const f32x4 a = *(const LAS f32x4*)(tab + rl * 16 + fq * 4);
    float s = (a.x + a.y) + (a.z + a.w); s += __shfl_xor(s, 16); s += __shfl_xor(s, 32);
    return rsqrtf(s * (1.0f / DM) + EPS);
}
#define EPI_FENCE() asm volatile("" ::: "memory")
#define LDS_WAIT() asm volatile("s_waitcnt lgkmcnt(0)" ::: "memory")

namespace pg8 {
constexpr int BM = 256, BK = 64, HALF = 128, HTB = HALF * BK * 2, NXCD = 8, WGM = 8;
__host__ __device__ __forceinline__ int lds_byte(int r, int c) { const int st = (r >> 4) * 2 + (c >> 5), rr = r & 15, cc = c & 31, ob = rr * 64 + cc * 2; return st * 1024 + (ob ^ (((ob >> 9) & 1) << 5)); }
__host__ __device__ __forceinline__ void stage_rc(int b, int& R, int& C) { const int st = b / 1024, sb = b % 1024, swz = sb ^ (((sb >> 9) & 1) << 5); R = (st >> 1) * 16 + swz / 64; C = (st & 1) * 32 + (swz % 64) / 2; }
__host__ __device__ __forceinline__ int perm32(int rho) { const int n = rho >> 4, i = rho & 15; return 8 * (i >> 2) + 4 * n + (i & 3); }

struct Unit { int pm, pn; };
struct Gemm { const bf16_t* A; const bf16_t* Bt; };

struct StaticOrder {
    int nM, nN, nwg, G, c;
    __device__ void init(int M_, int N_, int G_, int c_) { nM = M_ / BM; nN = N_ / BM; nwg = nM * nN; G = G_; c = c_; }
    __device__ bool next(int i, Unit& u) const {
        const long L = (long)i * G + c; if (L >= nwg) return false;
        int wgid = (int)L; { const int q = nwg / NXCD, r = nwg % NXCD, xcd = wgid % NXCD, off = wgid / NXCD; wgid = (xcd < r ? xcd * (q + 1) : r * (q + 1) + (xcd - r) * q) + off; }
        const int nig = WGM * nN, gid = wgid / nig, fm = gid * WGM, gsz = (nM - fm) < WGM ? (nM - fm) : WGM;
        u.pm = fm + ((wgid % nig) % gsz); u.pn = (wgid % nig) / gsz; return true;
    }
};

typedef f32x4 Acc[2][2][4][2];

struct EpiWin {
    static constexpr bool PREF = true;
    bf16_t* RX; bf16_t* CX; const float* ssq; const LAS float* tab;
    __device__ __forceinline__ void operator()(const Acc& acc, const Unit& u, int wr, int wc, int fr, int fq) const {
        const int row0 = u.pm * BM + wr * 64 + fr;
        float rsv[2][4];
#pragma unroll
        for (int ai = 0; ai < 2; ++ai)
#pragma unroll
            for (int m = 0; m < 4; ++m) rsv[ai][m] = row_rstd_lds(tab, wr * 64 + fr + ai * HALF + m * 16, fq);
        EPI_FENCE();
        if (u.pn < 4) {
#pragma unroll
            for (int ai = 0; ai < 2; ++ai)
#pragma unroll
                for (int m = 0; m < 4; ++m) { const int row = row0 + ai * HALF + m * 16; const float rs = rsv[ai][m];
                    bf16_t* rp = RX + (size_t)row * DM + u.pn * BM + wc * 32 + 8 * fq;
#pragma unroll
                    for (int bj = 0; bj < 2; ++bj) { const u32x2 p0 = pack4(acc[ai][bj][m][0] * rs), p1 = pack4(acc[ai][bj][m][1] * rs);
                        *(u32x4*)(rp + bj * HALF) = (u32x4){p0.x, p0.y, p1.x, p1.y}; } EPI_FENCE(); }
        } else {
            const int q = (u.pn - 4) >> 3, j = (u.pn - 4) & 7;
            bf16_t* dst = CX + (size_t)q * (size_t)(32u << 20) + j * 128 + wc * 32 + 8 * fq;
#pragma unroll
            for (int ai = 0; ai < 2; ++ai)
#pragma unroll
                for (int m = 0; m < 4; ++m) { const int row = row0 + ai * HALF + m * 16; const float rs = rsv[ai][m];
                    u32x4 w;
#pragma unroll
                    for (int n = 0; n < 2; ++n) { const f32x4 v0 = acc[ai][0][m][n] * rs, v1 = acc[ai][1][m][n] * rs; f32x4 o;
                        if (q == 0) o = v0 * v1;
                        else if (q == 1) { const f32x4 t = (v0 * v0 * 0.044715f + 1.0f) * v0 * 1.5957691216057308f;
                            o = v0 * rcp4((exp2n4(t) + 1.0f) * (exp2n4(v1) + 1.0f)); }
                        else o = v0 * sigm4(v1);
                        const u32x2 p = pack4(o); if (n == 0) { w.x = p.x; w.y = p.y; } else { w.z = p.x; w.w = p.y; } }
                    *(u32x4*)(dst + (size_t)row * DM) = w; EPI_FENCE(); }
        }
    }
};
struct EpiGate {
    static constexpr bool PREF = false;
    bf16_t* PR; bf16_t* PI; const float* br; const float* bi;
    __device__ __forceinline__ void operator()(const Acc& acc, const Unit& u, int wr, int wc, int fr, int fq) const {
        const int row0 = u.pm * BM + wr * 64 + fr;
        const int c0 = (u.pn >> 1) * 256 + (u.pn & 1) * 128 + wc * 32 + 8 * fq;
        const f32x4 br0 = *(const f32x4*)(br + c0), br1 = *(const f32x4*)(br + c0 + 4), bi0 = *(const f32x4*)(bi + c0), bi1 = *(const f32x4*)(bi + c0 + 4);
#pragma unroll
        for (int ai = 0; ai < 2; ++ai)
#pragma unroll
            for (int m = 0; m < 4; ++m) { const int row = row0 + ai * HALF + m * 16; const unsigned off = (unsigned)row * DM + c0;
                const u32x2 r0 = pack4(acc[ai][0][m][0] + br0), r1 = pack4(acc[ai][0][m][1] + br1), i0 = pack4(acc[ai][1][m][0] + bi0), i1 = pack4(acc[ai][1][m][1] + bi1);
                *(u32x4*)(PR + off) = (u32x4){r0.x, r0.y, r1.x, r1.y}; *(u32x4*)(PI + off) = (u32x4){i0.x, i0.y, i1.x, i1.y}; EPI_FENCE(); }
    }
};
struct EpiRes {
    static constexpr bool PREF = false;
    const bf16_t* xin; bf16_t* xout; float* ssq;
    __device__ __forceinline__ void operator()(const Acc& acc, const Unit& u, int wr, int wc, int fr, int fq) const {
        const int row0 = u.pm * BM + wr * 64 + fr; const int col0 = u.pn * BM + wc * 32 + 8 * fq;
#pragma unroll
        for (int ai = 0; ai < 2; ++ai) {
            u32x4 xw[4][2];
#pragma unroll
            for (int m = 0; m < 4; ++m)
#pragma unroll
                for (int bj = 0; bj < 2; ++bj) xw[m][bj] = *(const u32x4*)(xin + (unsigned)(row0 + ai * HALF + m * 16) * DM + col0 + bj * HALF);
            EPI_FENCE();
            float ssv[4];
#pragma unroll
            for (int m = 0; m < 4; ++m) { const int row = row0 + ai * HALF + m * 16; float ss = 0.f;
#pragma unroll
                for (int bj = 0; bj < 2; ++bj) { const unsigned off = (unsigned)row * DM + col0 + bj * HALF;
                    const f32x4 v0 = unpack4v((u32x2){xw[m][bj].x, xw[m][bj].y}) + acc[ai][bj][m][0], v1 = unpack4v((u32x2){xw[m][bj].z, xw[m][bj].w}) + acc[ai][bj][m][1];
                    const f32x4 q = v0 * v0 + v1 * v1; ss += (q.x + q.y) + (q.z + q.w);
                    const u32x2 p0 = pack4(v0), p1 = pack4(v1); *(u32x4*)(xout + off) = (u32x4){p0.x, p0.y, p1.x, p1.y}; }
                ss += __shfl_xor(ss, 16); ss += __shfl_xor(ss, 32); ssv[m] = ss; }
            ssq[(size_t)(row0 + ai * HALF + fq * 16) * 16 + u.pn * 4 + wc] = (fq == 0) ? ssv[0] : ((fq == 1) ? ssv[1] : ((fq == 2) ? ssv[2] : ssv[3]));
            EPI_FENCE();
        }
    }
};
struct EpiPle {
    static constexpr bool PREF = true;
    const bf16_t* xin; bf16_t* xout; const bf16_t* E; const float* ssq; float* ssq_out; const LAS float* tab;
    __device__ __forceinline__ void operator()(const Acc& acc, const Unit& u, int wr, int wc, int fr, int fq) const {
        const int row0 = u.pm * BM + wr * 64 + fr; const int col0 = u.pn * BM + wc * 32 + 8 * fq;
        float rsv[2][4];
#pragma unroll
        for (int ai = 0; ai < 2; ++ai)
#pragma unroll
            for (int m = 0; m < 4; ++m) rsv[ai][m] = row_rstd_lds(tab, wr * 64 + fr + ai * HALF + m * 16, fq);
        EPI_FENCE();
#pragma unroll
        for (int ai = 0; ai < 2; ++ai)
#pragma unroll
            for (int mh = 0; mh < 4; mh += 2) {
                u32x4 xw[2][2], ew[2][2]; float ssv2[2];
#pragma unroll
                for (int m = 0; m < 2; ++m)
#pragma unroll
                    for (int bj = 0; bj < 2; ++bj) { const unsigned off = (unsigned)(row0 + ai * HALF + (mh + m) * 16) * DM + col0 + bj * HALF; xw[m][bj] = *(const u32x4*)(xin + off); ew[m][bj] = *(const u32x4*)(E + off); }
                EPI_FENCE();
#pragma unroll
                for (int m = 0; m < 2; ++m) { const int row = row0 + ai * HALF + (mh + m) * 16; const float rs = rsv[ai][mh + m]; float ss = 0.f;
#pragma unroll
                    for (int bj = 0; bj < 2; ++bj) { const unsigned off = (unsigned)row * DM + col0 + bj * HALF;
                        const f32x4 v0 = unpack4v((u32x2){xw[m][bj].x, xw[m][bj].y}) + sigm4(acc[ai][bj][mh + m][0] * rs) * unpack4v((u32x2){ew[m][bj].x, ew[m][bj].y});
                        const f32x4 v1 = unpack4v((u32x2){xw[m][bj].z, xw[m][bj].w}) + sigm4(acc[ai][bj][mh + m][1] * rs) * unpack4v((u32x2){ew[m][bj].z, ew[m][bj].w});
                        const f32x4 q = v0 * v0 + v1 * v1; ss += (q.x + q.y) + (q.z + q.w);
                        const u32x2 p0 = pack4(v0), p1 = pack4(v1); *(u32x4*)(xout + off) = (u32x4){p0.x, p0.y, p1.x, p1.y}; }
                    ss += __shfl_xor(ss, 16); ss += __shfl_xor(ss, 32); ssv2[m] = ss; }
                if (fq < 2) ssq_out[(size_t)(row0 + ai * HALF + (mh + fq) * 16) * 16 + u.pn * 4 + wc] = (fq == 0) ? ssv2[0] : ssv2[1];
                EPI_FENCE();
            }
    }
};
struct EpiSwi {
    static constexpr bool PREF = true;
    bf16_t* ACT; const float* ssq; const LAS float* tab;
    __device__ __forceinline__ void operator()(const Acc& acc, const Unit& u, int wr, int wc, int fr, int fq) const {
        const int row0 = u.pm * BM + wr * 64 + fr; const int col0 = u.pn * 128 + wc * 32 + 8 * fq;
        float rsv[2][4];
#pragma unroll
        for (int ai = 0; ai < 2; ++ai)
#pragma unroll
            for (int m = 0; m < 4; ++m) rsv[ai][m] = row_rstd_lds(tab, wr * 64 + fr + ai * HALF + m * 16, fq);
        EPI_FENCE();
#pragma unroll
        for (int ai = 0; ai < 2; ++ai)
#pragma unroll
            for (int m = 0; m < 4; ++m) { const int row = row0 + ai * HALF + m * 16; const float rs = rsv[ai][m];
                const f32x4 g0 = acc[ai][0][m][0] * rs, g1 = acc[ai][0][m][1] * rs;
                const u32x2 p0 = pack4(g0 * sigm4(g0) * (acc[ai][1][m][0] * rs)), p1 = pack4(g1 * sigm4(g1) * (acc[ai][1][m][1] * rs));
                *(u32x4*)(ACT + (size_t)row * DFF + col0) = (u32x4){p0.x, p0.y, p1.x, p1.y}; EPI_FENCE(); }
    }
};
struct EpiBf {
    static constexpr bool PREF = false;
    bf16_t* O; int ldc;
    __device__ __forceinline__ void operator()(const Acc& acc, const Unit& u, int wr, int wc, int fr, int fq) const {
        const int row0 = u.pm * BM + wr * 64 + fr; const int col0 = u.pn * BM + wc * 32 + 8 * fq;
#pragma unroll
        for (int ai = 0; ai < 2; ++ai)
#pragma unroll
            for (int m = 0; m < 4; ++m) { const int row = row0 + ai * HALF + m * 16;
#pragma unroll
                for (int bj = 0; bj < 2; ++bj) { float v[8];
#pragma unroll
                    for (int e = 0; e < 8; ++e) v[e] = acc[ai][bj][m][e >> 2][e & 3];
                    *(u32x4*)(O + (size_t)row * ldc + col0 + bj * HALF) = pack8(v); } EPI_FENCE(); }
    }
};

template <int K, int LDA, int LDB, int ACS, int KREP = 1, class Epi>
__device__ __forceinline__ void gemm_phase(LAS unsigned char* lds, const int tid, const Gemm g, const StaticOrder& S, const Epi& E) {
    const int wid = __builtin_amdgcn_readfirstlane(tid >> 6), lane = tid & 63, wr = wid >> 2, wc = wid & 3, fr = lane & 15, fq = lane >> 4;
    constexpr int nt = K / BK;
    unsigned voffA[2], voffB[2];
#pragma unroll
    for (int i = 0; i < 2; ++i) { int R, C; stage_rc(tid * 16 + i * 8192, R, C); const int Rb = (R & ~31) + perm32(R & 31);
        voffA[i] = (unsigned)(R * LDA + C) * 2u; voffB[i] = (unsigned)(Rb * LDB + C) * 2u; }
    constexpr size_t kstep = (size_t)(BK * 2);
    constexpr size_t hstepA = (size_t)HALF * LDA * 2, hstepB = (size_t)HALF * LDB * 2;
    constexpr size_t tstepA = 2 * hstepA, tstepB = 2 * hstepB;
    const unsigned ldsw = (unsigned)wid * 1024u;
    const int aoff = lds_byte(wr * 64 + fr, fq * 8), boff = lds_byte(wc * 32 + fr, fq * 8);
#define PG8_SA(b, h) (((b) * 2 + (h)) * HTB)
#define PG8_SB(b, h) ((4 + (b) * 2 + (h)) * HTB)
#define PG8_STAGE(bufoff, gbase, voff) do { _Pragma("unroll") for (int _i = 0; _i < 2; ++_i) \
        __builtin_amdgcn_global_load_lds((const unsigned*)((const char*)(gbase) + (voff)[_i]), (LAS unsigned*)(lds + (bufoff) + ldsw + _i * 8192), 16, 0, 0); } while (0)
#define PG8_LDA(dst, b, h) do { _Pragma("unroll") for (int m = 0; m < 4; ++m) _Pragma("unroll") for (int k = 0; k < 2; ++k) dst[m][k] = *(const LAS bf16x8*)(lds + PG8_SA(b, h) + aoff + m * 2048 + k * 1024); } while (0)
#define PG8_LDB(dst, b, h) do { _Pragma("unroll") for (int n = 0; n < 2; ++n) _Pragma("unroll") for (int k = 0; k < 2; ++k) dst[n][k] = *(const LAS bf16x8*)(lds + PG8_SB(b, h) + boff + n * 2048 + k * 1024); } while (0)
#define PG8_MMA(ai, bj, At, Bt) do { __builtin_amdgcn_s_setprio(1); _Pragma("unroll") for (int m = 0; m < 4; ++m) _Pragma("unroll") for (int n = 0; n < 2; ++n) _Pragma("unroll") for (int k = 0; k < 2; ++k) \
        acc[ai][bj][m][n] = __builtin_amdgcn_mfma_f32_16x16x32_bf16(Bt[n][k], At[m][k], acc[ai][bj][m][n], 0, 0, 0); __builtin_amdgcn_s_setprio(0); } while (0)
#define PG8_WAIT_V(n) asm volatile("s_waitcnt vmcnt(" #n ")" ::: "memory")
#define PG8_WAIT_L(n) asm volatile("s_waitcnt lgkmcnt(" #n ")" ::: "memory")
#define PG8_BAR __builtin_amdgcn_s_barrier()
#define PG8_SCHED __builtin_amdgcn_sched_barrier(0)
    Unit cur, nxt; int ui = 0;
    if (!S.next(0, cur)) return;
    Acc acc;
#pragma unroll
    for (int a = 0; a < 2; ++a)
#pragma unroll
        for (int b = 0; b < 2; ++b)
#pragma unroll
            for (int m = 0; m < 4; ++m)
#pragma unroll
                for (int n = 0; n < 2; ++n) acc[a][b][m][n] = (f32x4){0.f, 0.f, 0.f, 0.f};
    bf16x8 At[4][2], B0[2][2], B1[2][2];
    const char* cA = (const char*)g.A + (size_t)cur.pm * tstepA + (size_t)((cur.pn >> 1) * ACS) * 2; const char* cB = (const char*)g.Bt + (size_t)cur.pn * tstepB;
    PG8_STAGE(PG8_SB(0, 0), cB, voffB); PG8_STAGE(PG8_SB(0, 1), cB + hstepB, voffB); PG8_STAGE(PG8_SA(0, 0), cA, voffA); PG8_STAGE(PG8_SA(0, 1), cA + hstepA, voffA);
    if (wr == 1) PG8_BAR;
    PG8_WAIT_V(2); PG8_BAR;
    PG8_STAGE(PG8_SB(1, 0), cB + kstep, voffB); PG8_STAGE(PG8_SA(1, 0), cA + kstep, voffA); PG8_STAGE(PG8_SB(1, 1), cB + hstepB + kstep, voffB);
    PG8_WAIT_V(6); PG8_BAR;
    for (;;) {
        const bool has_next = S.next(ui + 1, nxt);
        const char* nA = has_next ? (const char*)g.A + (size_t)nxt.pm * tstepA + (size_t)((nxt.pn >> 1) * ACS) * 2 : cA; const char* nB = has_next ? (const char*)g.Bt + (size_t)nxt.pn * tstepB : cB;
#pragma unroll 1
        for (int tt = 0; tt < nt * KREP; tt += 2) {
            const int t = (KREP == 1) ? tt : tt % nt;
            const bool last = (t == nt - 2), lastrep = (KREP == 1) || (tt == nt * KREP - 2);
            const char* a1 = cA + (size_t)(t + 1) * kstep;
            const char* a2 = last ? (lastrep ? nA : cA) : cA + (size_t)(t + 2) * kstep; const char* b2 = last ? (lastrep ? nB : cB) : cB + (size_t)(t + 2) * kstep;
            const char* a3 = a2 + kstep; const char* b3 = b2 + kstep;
            PG8_LDB(B0, 0, 0); PG8_LDB(B1, 0, 1); PG8_SCHED; PG8_LDA(At, 0, 0); PG8_STAGE(PG8_SA(1, 1), a1 + hstepA, voffA);
            PG8_WAIT_V(8); PG8_WAIT_L(0); PG8_BAR; PG8_MMA(0, 0, At, B0); PG8_MMA(0, 1, At, B1); PG8_BAR; PG8_SCHED;
            if constexpr (Epi::PREF) { if (tt == 0) {
#pragma unroll
                for (int q_ = 0; q_ < 2; ++q_) { const int p_ = 2 * wc + q_, rl_ = (p_ >> 2) * HALF + wr * 64 + (p_ & 3) * 16;
                    __builtin_amdgcn_global_load_lds((const unsigned*)(E.ssq + ((size_t)cur.pm * BM + rl_) * 16 + lane * 4), (LAS unsigned*)(lds + SSQ_TAB_OFF + rl_ * 64), 16, 0, 0); } }
                PG8_SCHED; }
            PG8_LDA(At, 0, 1); PG8_STAGE(PG8_SB(0, 0), b2, voffB); PG8_STAGE(PG8_SB(0, 1), b2 + hstepB, voffB); PG8_STAGE(PG8_SA(0, 0), a2, voffA);
            PG8_WAIT_V(8); PG8_WAIT_L(0); PG8_BAR; PG8_MMA(1, 0, At, B0); PG8_MMA(1, 1, At, B1); PG8_BAR; PG8_SCHED;
            PG8_LDB(B0, 1, 0); PG8_LDB(B1, 1, 1); PG8_SCHED; PG8_LDA(At, 1, 0); PG8_STAGE(PG8_SA(0, 1), a2 + hstepA, voffA);
            PG8_WAIT_V(8); PG8_WAIT_L(0); PG8_BAR; PG8_MMA(0, 0, At, B0); PG8_MMA(0, 1, At, B1); PG8_BAR; PG8_SCHED;
            PG8_LDA(At, 1, 1); PG8_STAGE(PG8_SB(1, 0), b3, voffB); PG8_STAGE(PG8_SB(1, 1), b3 + hstepB, voffB); PG8_STAGE(PG8_SA(1, 0), a3, voffA);
            PG8_WAIT_V(8); PG8_WAIT_L(0); PG8_BAR; PG8_MMA(1, 0, At, B0); PG8_MMA(1, 1, At, B1); PG8_BAR; PG8_SCHED;
        }
        if (wr == 0) PG8_BAR;
        if constexpr (KREP != 1) {
#pragma unroll
            for (int a = 0; a < 2; ++a)
#pragma unroll
                for (int b = 0; b < 2; ++b)
#pragma unroll
                    for (int m = 0; m < 4; ++m)
#pragma unroll
                        for (int n = 0; n < 2; ++n) acc[a][b][m][n] = acc[a][b][m][n] * (1.0f / KREP);
        }
        E(acc, cur, wr, wc, fr, fq);
        if (!has_next) break;
#pragma unroll
        for (int a = 0; a < 2; ++a)
#pragma unroll
            for (int b = 0; b < 2; ++b)
#pragma unroll
                for (int m = 0; m < 4; ++m)
#pragma unroll
                    for (int n = 0; n < 2; ++n) acc[a][b][m][n] = (f32x4){0.f, 0.f, 0.f, 0.f};
        cur = nxt; cA = nA; cB = nB; ++ui;
        if (wr == 1) PG8_BAR;
    }
    PG8_WAIT_V(0);
    PG8_BAR;
#undef PG8_SA
#undef PG8_SB
#undef PG8_STAGE
#undef PG8_LDA
#undef PG8_LDB
#undef PG8_MMA
#undef PG8_WAIT_V
#undef PG8_WAIT_L
#undef PG8_BAR
#undef PG8_SCHED
}
}

__device__ __forceinline__ void wconv_item(const float* src, int ldsrc, const float* gain, bf16_t* dst, int lddst, LAS float* scr, int lane) {
    float wv[32];
#pragma unroll
    for (int i = 0; i < 32; ++i) { const int kk = 2 * i + (lane >> 5); wv[i] = src[(size_t)kk * ldsrc + (lane & 31)]; }
    if (gain) {
#pragma unroll
        for (int i = 0; i < 32; ++i) wv[i] *= gain[2 * i + (lane >> 5)]; }
#pragma unroll
    for (int i = 0; i < 32; ++i) { const int kk = 2 * i + (lane >> 5); scr[kk * 33 + (lane & 31)] = wv[i]; }
    LDS_WAIT(); asm volatile("" ::: "memory");
    const int c = lane & 7;
#pragma unroll
    for (int j = 0; j < 4; ++j) { const int n = (lane >> 3) + 8 * j; const LAS float* s = scr + (8 * c) * 33 + n;
        u32x4 o; o.x = cvt_pk_bf16(s[0 * 33], s[1 * 33]); o.y = cvt_pk_bf16(s[2 * 33], s[3 * 33]); o.z = cvt_pk_bf16(s[4 * 33], s[5 * 33]); o.w = cvt_pk_bf16(s[6 * 33], s[7 * 33]);
        *(u32x4*)(dst + (size_t)n * lddst + 8 * c) = o; }
    LDS_WAIT(); asm volatile("" ::: "memory");
}
__device__ __forceinline__ int win_src_col(int n0) {
    const int pn = n0 >> 8, rr = n0 & 255;
    if (pn < 4) return n0;
    const int q = (pn - 4) >> 3, j = (pn - 4) & 7, half = rr >> 7, off = rr & 127;
    int base;
    if (q == 0) base = half ? 4096 : 3072;
    else if (q == 1) base = half ? 5120 : 1024;
    else base = half ? 6144 : 2048;
    return base + 128 * j + off;
}


#define XB_TMO      128
#define XB_XCNT(j)  (256  + 64 * (j))
#define XB_XSUB(j)  (1280 + 64 * (j))
#define XB_XGEN(j)  (2304 + 64 * (j))
#define XB_TOP      3328
#define XB_TOPGEN   3392
#define XCD_BAR_WORDS 3456
#define XB_SPIN_CAP (1u << 18)
__device__ __forceinline__ unsigned xb_ld(unsigned* p)              { return __hip_atomic_load(p, __ATOMIC_RELAXED, __HIP_MEMORY_SCOPE_AGENT); }
__device__ __forceinline__ unsigned xb_add(unsigned* p, unsigned v) { return __hip_atomic_fetch_add(p, v, __ATOMIC_RELAXED, __HIP_MEMORY_SCOPE_AGENT); }
__device__ __forceinline__ unsigned xb_xcc_id() { return (unsigned)__builtin_amdgcn_s_getreg((3 << 11) | 20) & 0xFu; }
#define XB_SPIN(cond, bar) do { unsigned _sp = 0; while (cond) { __builtin_amdgcn_s_sleep(1); \
    if ((++_sp & 255u) == 0u) { if (xb_ld(&(bar)[XB_TMO])) break; if (_sp > XB_SPIN_CAP) { atomicAdd(&(bar)[XB_TMO], 1u); break; } } } } while (0)
struct XcdBarrier { unsigned* bar; unsigned x; volatile LAS unsigned* st; };
__device__ __forceinline__ XcdBarrier xcd_barrier_post(unsigned* bar, volatile LAS unsigned* st) {
    XcdBarrier b; b.bar = bar; b.x = xb_xcc_id(); b.st = st;
    if (threadIdx.x == 0) (void)xb_add(&bar[XB_XCNT(b.x)], 1u);
    return b;
}
__device__ __forceinline__ void xcd_barrier_complete(unsigned* bar, unsigned x, unsigned& nloc, unsigned& nx) {
    const unsigned G = gridDim.x * gridDim.y * gridDim.z;
    unsigned sum, cnt, mine, sp = 0u;
    for (;;) {
        sum = 0u; cnt = 0u; mine = 0u;
#pragma unroll
        for (unsigned j = 0; j < 16; ++j) { const unsigned c = xb_ld(&bar[XB_XCNT(j)]); sum += c; cnt += (c > 0u) ? 1u : 0u; mine = (j == x) ? c : mine; }
        if (sum == G) break;
        __builtin_amdgcn_s_sleep(1);
        if ((++sp & 255u) == 0u) { if (xb_ld(&bar[XB_TMO])) break; if (sp > XB_SPIN_CAP) { atomicAdd(&bar[XB_TMO], 1u); break; } }
    }
    nloc = mine > 0u ? mine : 1u; nx = cnt > 0u ? cnt : 1u;
}
__device__ __forceinline__ void xcd_barrier(const XcdBarrier& b) {
    asm volatile("s_waitcnt vmcnt(0)" ::: "memory");
    __syncthreads();
    if (threadIdx.x == 0) {
        unsigned* bar = b.bar;
        __builtin_amdgcn_s_waitcnt(0);
        unsigned nloc = b.st[0], nx = b.st[1];
        if (nloc == 0u) { xcd_barrier_complete(bar, b.x, nloc, nx); b.st[0] = nloc; b.st[1] = nx; }
        const unsigned old = xb_add(&bar[XB_XSUB(b.x)], 1u);
        const unsigned gen = old / nloc;
        if (old + 1u == (gen + 1u) * nloc) {
            __builtin_amdgcn_fence(__ATOMIC_RELEASE, "agent");
            asm volatile("s_waitcnt vmcnt(0)" ::: "memory");
            const unsigned og = xb_add(&bar[XB_TOP], 1u);
            const unsigned tg = og / nx;
            if (og + 1u == (tg + 1u) * nx) xb_add(&bar[XB_TOPGEN], 1u);
            else XB_SPIN(xb_ld(&bar[XB_TOPGEN]) == tg, bar);
            __builtin_amdgcn_fence(__ATOMIC_ACQUIRE, "agent");
            xb_add(&bar[XB_XGEN(b.x)], 1u);
            asm volatile("s_waitcnt vmcnt(0)" ::: "memory");
        } else {
            XB_SPIN(xb_ld(&bar[XB_XGEN(b.x)]) == gen, bar);
            __builtin_amdgcn_fence(__ATOMIC_ACQUIRE, "agent");
            asm volatile("s_waitcnt vmcnt(0)" ::: "memory");
        }
    }
    __syncthreads();
}

struct Args { const float* in[20]; float* out; unsigned char* ws; int ph_lo, ph_hi; };

struct Ctx {
    const float* const* in; unsigned char* ws; float* X; LAS unsigned char* lds;
    int tid, lane, wave, gtid, NT, gw, NGW, G;
};

__device__ __forceinline__ void conv_early(const Ctx& c, int l) {
    LAS float* scr = (LAS float*)(c.lds + c.wave * 16384);
    bf16_t* WINT = (bf16_t*)(c.ws + WS_WIN); bf16_t* WGT = (bf16_t*)(c.ws + WS_WG);
    const float* w_in = c.in[3] + (size_t)l * DM * WIN; const float* g_mix = c.in[2] + l * DM;
    const float* wr_ = c.in[6] + (size_t)l * 262144; const float* wi_ = c.in[8] + (size_t)l * 262144;
    constexpr int I_WIN = 16 * 224, I_G = 4 * 64;
    for (int it = c.gw; it < I_WIN + I_G; it += c.NGW) {
        if (it < I_WIN) { const int kb = it / 224, nb = it % 224, k0 = 64 * kb, n0 = 32 * nb;
            wconv_item(w_in + (size_t)k0 * WIN + win_src_col(n0), WIN, g_mix + k0, WINT + (size_t)n0 * DM + k0, DM, scr, c.lane); }
        else { const int r = it - I_WIN, kb = r / 64, nb = r % 64, k0 = 64 * kb, n0 = 32 * nb;
            const int h = n0 >> 9, jt = (n0 >> 8) & 1, half = (n0 >> 7) & 1, off = n0 & 127;
            const float* src = (half ? wi_ : wr_) + (size_t)h * 65536 + (size_t)k0 * 256 + 128 * jt + off;
            wconv_item(src, 256, nullptr, WGT + (size_t)n0 * 256 + k0, 256, scr, c.lane); }
    }
}
__device__ __forceinline__ void conv_late(const Ctx& c, int l) {
    LAS float* scr = (LAS float*)(c.lds + c.wave * 16384);
    bf16_t* WOUT = (bf16_t*)(c.ws + WS_WOUT); bf16_t* WGU = (bf16_t*)(c.ws + WS_WGU); bf16_t* WDN = (bf16_t*)(c.ws + WS_WDN); bf16_t* WPG = (bf16_t*)(c.ws + WS_WPG); bf16_t* WPLE = (bf16_t*)(c.ws + WS_WPLE);
    const float* w_out = c.in[12] + (size_t)l * DM * DM; const float* g_ffn = c.in[13] + l * DM; const float* w_gu = c.in[14] + (size_t)l * DM * 2 * DFF;
    const float* w_dn = c.in[15] + (size_t)l * DFF * DM; const float* g_ple = c.in[16] + l * DM; const float* w_pg = c.in[17] + (size_t)l * DM * DM; const float* w_ple = c.in[18] + (size_t)l * PLE * DM;
    constexpr int I_O = 16 * 32, I_GU = 16 * 176, I_DN = 44 * 32, I_PG = 16 * 32, I_PL = 4 * 32;
    for (int it = c.gw; it < I_O + I_GU + I_DN + I_PG + I_PL; it += c.NGW) {
        int r = it;
        if (r < I_O) { const int kb = r / 32, nb = r % 32, k0 = 64 * kb, n0 = 32 * nb; wconv_item(w_out + (size_t)k0 * DM + n0, DM, nullptr, WOUT + (size_t)n0 * DM + k0, DM, scr, c.lane); continue; } r -= I_O;
        if (r < I_GU) { const int kb = r / 176, nb = r % 176, k0 = 64 * kb, n0 = 32 * nb; const int pn = n0 >> 8, half = (n0 >> 7) & 1, off = n0 & 127;
            wconv_item(w_gu + (size_t)k0 * (2 * DFF) + half * DFF + 128 * pn + off, 2 * DFF, g_ffn + k0, WGU + (size_t)n0 * DM + k0, DM, scr, c.lane); continue; } r -= I_GU;
        if (r < I_DN) { const int kb = r / 32, nb = r % 32, k0 = 64 * kb, n0 = 32 * nb; wconv_item(w_dn + (size_t)k0 * DM + n0, DM, nullptr, WDN + (size_t)n0 * DFF + k0, DFF, scr, c.lane); continue; } r -= I_DN;
        if (r < I_PG) { const int kb = r / 32, nb = r % 32, k0 = 64 * kb, n0 = 32 * nb; wconv_item(w_pg + (size_t)k0 * DM + n0, DM, g_ple + k0, WPG + (size_t)n0 * DM + k0, DM, scr, c.lane); continue; } r -= I_PG;
        { const int kb = r / 32, nb = r % 32, k0 = 64 * kb, n0 = 32 * nb; wconv_item(w_ple + (size_t)k0 * DM + n0, DM, nullptr, WPLE + (size_t)n0 * PLE + k0, PLE, scr, c.lane); }
    }
    const float* p = c.in[1] + (size_t)l * M * PLE; bf16_t* PB = (bf16_t*)(c.ws + WS_PB);
    for (int it0 = c.gtid; it0 < M * PLE / 8; it0 += 4 * c.NT) {
        f32x4 a[4], b[4];
#pragma unroll
        for (int q = 0; q < 4; ++q) { const int it = it0 + q * c.NT; if (it < M * PLE / 8) { a[q] = *(const f32x4*)(p + (size_t)it * 8); b[q] = *(const f32x4*)(p + (size_t)it * 8 + 4); } }
#pragma unroll
        for (int q = 0; q < 4; ++q) { const int it = it0 + q * c.NT; if (it < M * PLE / 8) {
            u32x4 w; w.x = cvt_pk_bf16(a[q].x, a[q].y); w.y = cvt_pk_bf16(a[q].z, a[q].w); w.z = cvt_pk_bf16(b[q].x, b[q].y); w.w = cvt_pk_bf16(b[q].z, b[q].w); *(u32x4*)(PB + (size_t)it * 8) = w; } }
    }
}

__device__ __forceinline__ float wave_sum(float v) {
#pragma unroll
    for (int o = 1; o < 64; o <<= 1) v += __shfl_xor(v, o);
    return v;
}

__device__ __forceinline__ void prologue(const Ctx& c) {
    const float* x = c.in[0]; bf16_t* XB = (bf16_t*)c.X; float* ssq1 = (float*)(c.ws + WS_SSQ1);
    for (int m0 = c.gw * 4; m0 < M; m0 += c.NGW * 4) {
        f32x4 v[4][4];
#pragma unroll
        for (int r = 0; r < 4; ++r) { const f32x4* xr = (const f32x4*)(x + (size_t)(m0 + r) * DM) + 2 * c.lane;
#pragma unroll
            for (int j = 0; j < 2; ++j) { v[r][2 * j] = xr[128 * j]; v[r][2 * j + 1] = xr[128 * j + 1]; } }
#pragma unroll
        for (int r = 0; r < 4; ++r) { const int m = m0 + r; float s = 0.f;
#pragma unroll
            for (int j = 0; j < 4; ++j) s += (v[r][j].x * v[r][j].x + v[r][j].y * v[r][j].y) + (v[r][j].z * v[r][j].z + v[r][j].w * v[r][j].w);
            s = wave_sum(s);
            u32x4* o = (u32x4*)(XB + (size_t)m * DM) + c.lane;
#pragma unroll
            for (int j = 0; j < 2; ++j) { u32x4 w; w.x = cvt_pk_bf16(v[r][2 * j].x, v[r][2 * j].y); w.y = cvt_pk_bf16(v[r][2 * j].z, v[r][2 * j].w); w.z = cvt_pk_bf16(v[r][2 * j + 1].x, v[r][2 * j + 1].y); w.w = cvt_pk_bf16(v[r][2 * j + 1].z, v[r][2 * j + 1].w); o[64 * j] = w; }
            if (c.lane < 16) ssq1[(size_t)m * 16 + c.lane] = (c.lane == 0) ? s : 0.f; }
    }
    float* sp8 = (float*)(c.ws + WS_SP8); const float* lam = c.in[10];
    for (int i = c.gtid; i < DEPTH * DM; i += c.NT) sp8[i] = 8.0f * log1pf(expf(-lam[i]));
    conv_early(c, 0);
}

__device__ __forceinline__ void conv4_phase(const Ctx& c, int l) {
    const bf16_t* RX = (const bf16_t*)(c.ws + WS_RX); bf16_t* XC = (bf16_t*)(c.ws + WS_XC);
    const float* w4 = c.in[4] + (size_t)l * 4 * DM; const float* b4 = c.in[5] + l * DM;
    for (int item = c.gtid; item < (M / 8) * 128; item += c.NT) {
        const int run = item >> 7, c0 = (item & 127) * 8, t0 = run * 8;
        float w[4][8], b[8];
#pragma unroll
        for (int k = 0; k < 4; ++k) { const f32x4 a = *(const f32x4*)(w4 + k * DM + c0), bb = *(const f32x4*)(w4 + k * DM + c0 + 4);
            w[k][0] = a.x; w[k][1] = a.y; w[k][2] = a.z; w[k][3] = a.w; w[k][4] = bb.x; w[k][5] = bb.y; w[k][6] = bb.z; w[k][7] = bb.w; }
        { const f32x4 a = *(const f32x4*)(b4 + c0), bb = *(const f32x4*)(b4 + c0 + 4); b[0] = a.x; b[1] = a.y; b[2] = a.z; b[3] = a.w; b[4] = bb.x; b[5] = bb.y; b[6] = bb.z; b[7] = bb.w; }
        float h0[8], h1[8], h2[8];
        if ((t0 & (SEQ - 1)) == 0) {
#pragma unroll
            for (int e = 0; e < 8; ++e) { h0[e] = 0.f; h1[e] = 0.f; h2[e] = 0.f; }
        } else {
            unpack8(*(const u32x4*)(RX + (size_t)(t0 - 3) * DM + c0), h0); unpack8(*(const u32x4*)(RX + (size_t)(t0 - 2) * DM + c0), h1); unpack8(*(const u32x4*)(RX + (size_t)(t0 - 1) * DM + c0), h2);
        }
        u32x4 wrow[8];
#pragma unroll
        for (int i = 0; i < 8; ++i) wrow[i] = *(const u32x4*)(RX + (size_t)(t0 + i) * DM + c0);
#pragma unroll
        for (int i = 0; i < 8; ++i) { float f[8], o[8]; unpack8(wrow[i], f);
#pragma unroll
            for (int e = 0; e < 8; ++e) { o[e] = b[e] + w[0][e] * h0[e] + w[1][e] * h1[e] + w[2][e] * h2[e] + w[3][e] * f[e]; h0[e] = h1[e]; h1[e] = h2[e]; h2[e] = f[e]; }
            *(u32x4*)(XC + (size_t)(t0 + i) * DM + c0) = pack8(o); }
    }
}

__device__ __forceinline__ f32x4 gate_em4(f32x4 x2) {
    f32x4 em = x2 * (x2 * (x2 * (x2 * (x2 * (x2 * 0.0013888889f + 0.0083333338f) + 0.041666668f) + 0.16666667f) + 0.5f) + 1.0f);
    if (__builtin_amdgcn_ballot_w64((x2.x <= -0.25f) | (x2.y <= -0.25f) | (x2.z <= -0.25f) | (x2.w <= -0.25f)) != 0ull) {
#pragma unroll
        for (int e = 0; e < 4; ++e) if (x2[e] <= -0.25f) em[e] = __expf(x2[e]) - 1.f; }
    return em;
}
__device__ __forceinline__ void gate_step4(f32x4 pr, f32x4 pi, f32x4 xc, f32x4 sp, f32x4& hl, f32x4& cp) {
    const f32x4 r = sigm4(pr), ig = sigm4(pi);
    const f32x4 lg = -(r * sp), em = gate_em4(lg + lg);
    f32x4 s; s.x = __builtin_amdgcn_sqrtf(-em.x); s.y = __builtin_amdgcn_sqrtf(-em.y); s.z = __builtin_amdgcn_sqrtf(-em.z); s.w = __builtin_amdgcn_sqrtf(-em.w);
    const f32x4 a = exp2n4(-lg);
    hl = a * hl + s * ig * xc; cp = cp * a;
}
__device__ __forceinline__ void scan_local(const Ctx& c, int l) {
    bf16_t* PR = (bf16_t*)(c.ws + WS_RX); bf16_t* PI = (bf16_t*)(c.ws + WS_U); const bf16_t* XC = (const bf16_t*)(c.ws + WS_XC);
    float* PS = (float*)(c.ws + WS_PS); float* HS = (float*)(c.ws + WS_HS); const float* sp8 = (const float*)(c.ws + WS_SP8) + l * DM;
    if (c.tid >= 256) return;
    for (int item = (c.gtid >> 9) * 256 + c.tid; item < NCHUNK * 128; item += c.G * 256) {
        const int chunk = item >> 7, c0 = (item & 127) * 8;
        const f32x4 sp0 = *(const f32x4*)(sp8 + c0), sp1 = *(const f32x4*)(sp8 + c0 + 4);
        f32x4 hl0 = (f32x4){0.f, 0.f, 0.f, 0.f}, hl1 = hl0, cp0 = (f32x4){1.f, 1.f, 1.f, 1.f}, cp1 = cp0;
        const size_t base = (size_t)chunk * LCH * DM + c0;
        u32x4 nr_[4], ni_[4], nx_[4];
#pragma unroll
        for (int j = 0; j < 4; ++j) { const size_t o = base + (size_t)j * DM; nr_[j] = *(const u32x4*)(PR + o); ni_[j] = *(const u32x4*)(PI + o); nx_[j] = *(const u32x4*)(XC + o); }
#pragma unroll 1
        for (int tb = 0; tb < LCH; tb += 4) {
            u32x4 wr_[4], wi_[4], wx_[4];
#pragma unroll
            for (int j = 0; j < 4; ++j) { wr_[j] = nr_[j]; wi_[j] = ni_[j]; wx_[j] = nx_[j]; }
            if (tb + 4 < LCH) {
#pragma unroll
                for (int j = 0; j < 4; ++j) { const size_t o = base + (size_t)(tb + 4 + j) * DM; nr_[j] = *(const u32x4*)(PR + o); ni_[j] = *(const u32x4*)(PI + o); nx_[j] = *(const u32x4*)(XC + o); } }
#pragma unroll
            for (int j = 0; j < 4; ++j) {
                gate_step4(unpack4v((u32x2){wr_[j].x, wr_[j].y}), unpack4v((u32x2){wi_[j].x, wi_[j].y}), unpack4v((u32x2){wx_[j].x, wx_[j].y}), sp0, hl0, cp0);
                gate_step4(unpack4v((u32x2){wr_[j].z, wr_[j].w}), unpack4v((u32x2){wi_[j].z, wi_[j].w}), unpack4v((u32x2){wx_[j].z, wx_[j].w}), sp1, hl1, cp1);
                const size_t o = base + (size_t)(tb + j) * DM;
                const u32x2 h0 = pack4(hl0), h1 = pack4(hl1), q0 = pack4(cp0), q1 = pack4(cp1);
                *(u32x4*)(PI + o) = (u32x4){h0.x, h0.y, h1.x, h1.y}; *(u32x4*)(PR + o) = (u32x4){q0.x, q0.y, q1.x, q1.y}; }
        }
        *(f32x4*)(PS + (size_t)chunk * DM + c0) = cp0; *(f32x4*)(PS + (size_t)chunk * DM + c0 + 4) = cp1;
        *(f32x4*)(HS + (size_t)chunk * DM + c0) = hl0; *(f32x4*)(HS + (size_t)chunk * DM + c0 + 4) = hl1;
    }
}
__device__ __forceinline__ void merge_phase(const Ctx& c, int l, unsigned bx) {
    const bf16_t* CP = (const bf16_t*)(c.ws + WS_RX); const bf16_t* HL = (const bf16_t*)(c.ws + WS_U); const bf16_t* CX = (const bf16_t*)(c.ws + WS_CX);
    const bf16_t* GY = (const bf16_t*)(c.ws + WS_GY); const bf16_t* GB = (const bf16_t*)(c.ws + WS_GB); bf16_t* MG = (bf16_t*)(c.ws + WS_XC);
    const float* PS = (const float*)(c.ws + WS_PS); const float* HS = (const float*)(c.ws + WS_HS); const float* w3 = c.in[11] + (size_t)l * 3 * DM;
    LAS float* carr = (LAS float*)c.lds;
    constexpr int CPS = SEQ / LCH;
    for (int rb = (int)bx; rb < M / 128; rb += c.G) {
        const int k0 = 2 * rb, kk0 = k0 % CPS, kbase = k0 - kk0;
        { const int c2 = 2 * c.tid; f32x2 carry = (f32x2){0.f, 0.f};
#pragma unroll 1
          for (int k = 0; k < kk0; k += 16) {
              f32x2 P[16], H[16];
#pragma unroll
              for (int j = 0; j < 16; ++j) { const int kc = (k + j < kk0) ? (k + j) : (kk0 - 1); P[j] = *(const f32x2*)(PS + (size_t)(kbase + kc) * DM + c2); H[j] = *(const f32x2*)(HS + (size_t)(kbase + kc) * DM + c2); }
#pragma unroll
              for (int j = 0; j < 16; ++j) { if (k + j < kk0) carry = P[j] * carry + H[j]; } }
          const f32x2 P = *(const f32x2*)(PS + (size_t)k0 * DM + c2), H = *(const f32x2*)(HS + (size_t)k0 * DM + c2);
          const f32x2 carry1 = P * carry + H;
          carr[c2] = carry.x; carr[c2 + 1] = carry.y; carr[DM + c2] = carry1.x; carr[DM + c2 + 1] = carry1.y; }
        __syncthreads();
#pragma unroll 1
        for (int it = 0; it < 4; ++it) {
            const int item = c.tid + 512 * it, run = item >> 7, c0 = (item & 127) * 8, t0 = rb * 128 + run * 8;
            float w[3][8], cr[8];
#pragma unroll
            for (int k = 0; k < 3; ++k) { const f32x4 a = *(const f32x4*)(w3 + k * DM + c0), bb = *(const f32x4*)(w3 + k * DM + c0 + 4);
                w[k][0] = a.x; w[k][1] = a.y; w[k][2] = a.z; w[k][3] = a.w; w[k][4] = bb.x; w[k][5] = bb.y; w[k][6] = bb.z; w[k][7] = bb.w; }
            { const LAS f32x4* cp4 = (const LAS f32x4*)(carr + (run >> 3) * DM + c0); const f32x4 a = cp4[0], bb = cp4[1]; cr[0] = a.x; cr[1] = a.y; cr[2] = a.z; cr[3] = a.w; cr[4] = bb.x; cr[5] = bb.y; cr[6] = bb.z; cr[7] = bb.w; }
            float p0[8], p1[8];
            if ((t0 & (SEQ - 1)) == 0) {
#pragma unroll
                for (int e = 0; e < 8; ++e) { p0[e] = 0.f; p1[e] = 0.f; }
            } else { unpack8(*(const u32x4*)(CX + (size_t)(t0 - 2) * DM + c0), p0); unpack8(*(const u32x4*)(CX + (size_t)(t0 - 1) * DM + c0), p1); }
#pragma unroll
            for (int ib = 0; ib < 8; ib += 4) {
                u32x4 whl[4], wcp[4], wgy[4], wgb[4], wcx[4];
#pragma unroll
                for (int i = 0; i < 4; ++i) { const size_t off = (size_t)(t0 + ib + i) * DM + c0;
                    whl[i] = *(const u32x4*)(HL + off); wcp[i] = *(const u32x4*)(CP + off); wgy[i] = *(const u32x4*)(GY + off); wgb[i] = *(const u32x4*)(GB + off); wcx[i] = *(const u32x4*)(CX + off); }
#pragma unroll
                for (int i = 0; i < 4; ++i) { const size_t off = (size_t)(t0 + ib + i) * DM + c0;
                    float hl[8], cp[8], gy[8], gb[8], cx[8], o[8];
                    unpack8(whl[i], hl); unpack8(wcp[i], cp); unpack8(wgy[i], gy); unpack8(wgb[i], gb); unpack8(wcx[i], cx);
#pragma unroll
                    for (int e = 0; e < 8; ++e) { const float h = hl[e] + cp[e] * cr[e]; o[e] = gy[e] * h + gb[e] * (w[0][e] * p0[e] + w[1][e] * p1[e] + w[2][e] * cx[e]); p0[e] = p1[e]; p1[e] = cx[e]; }
                    *(u32x4*)(MG + off) = pack8(o); }
            }
        }
        __syncthreads();
    }
}
__device__ __forceinline__ void final_phase(const Ctx& c) {
    const float* ssq = (const float*)(c.ws + WS_SSQ1); const float* g = c.in[19]; const bf16_t* xl = (const bf16_t*)(c.ws + WS_XC);
    f32x4 gv[4];
#pragma unroll
    for (int j = 0; j < 4; ++j) gv[j] = ((const f32x4*)g)[c.lane + 64 * j];
    for (int m0 = c.gw * 4; m0 < M; m0 += c.NGW * 4) {
        u32x2 xw[4][4]; float rs[4];
#pragma unroll
        for (int r = 0; r < 4; ++r) { const u32x2* xr = (const u32x2*)(xl + (size_t)(m0 + r) * DM) + c.lane; rs[r] = row_rstd(ssq, m0 + r);
#pragma unroll
            for (int j = 0; j < 4; ++j) xw[r][j] = xr[64 * j]; }
#pragma unroll
        for (int r = 0; r < 4; ++r) { f32x4* orow = (f32x4*)((float*)c.X + (size_t)(m0 + r) * DM) + c.lane;
#pragma unroll
            for (int j = 0; j < 4; ++j) orow[64 * j] = unpack4v(xw[r][j]) * rs[r] * gv[j]; }
    }
}

__global__ void __launch_bounds__(512, 2) fwd_mega(Args a) {
    extern __shared__ __attribute__((aligned(16))) unsigned char lds_raw[];
    cg::grid_group grid = cg::this_grid();
    volatile LAS unsigned* bst = (volatile LAS unsigned*)((LAS unsigned char*)lds_raw + RING_BYTES + 256);
    if (threadIdx.x < 8) bst[threadIdx.x] = 0u;
    __syncthreads();
    const XcdBarrier xbar = xcd_barrier_post((unsigned*)(a.ws + WS_BAR), bst);
    unsigned* xcnt = (unsigned*)(a.ws + WS_BAR) + 3584;
    if (threadIdx.x == 0) bst[4] = xb_add(&xcnt[64 * xbar.x], 1u);
    __syncthreads();
    const unsigned my_rank = (unsigned)__builtin_amdgcn_readfirstlane((int)bst[4]);
    unsigned vcu = blockIdx.x; bool vcu_known = false;
#ifndef KREP_WIN
#define KREP_WIN 1
#endif
#ifndef DUPMASK
#define DUPMASK 0
#endif
#ifndef EXTRA_SYNCS
#define EXTRA_SYNCS 0
#endif
    bool dup_done = false;
    for (int ph = a.ph_lo; ph < a.ph_hi; ++ph) {
        if (!vcu_known && ph > a.ph_lo) {
            bool ok = (gridDim.x % 8u) == 0u;
            for (unsigned j = 0; j < 8; ++j) ok = ok && ((unsigned)__builtin_amdgcn_readfirstlane((int)xb_ld(&xcnt[64 * j])) == gridDim.x / 8u);
            if (ok && xbar.x < 8u && my_rank < gridDim.x / 8u) vcu = my_rank * 8u + xbar.x;
            vcu_known = true;
        }
        int tid_ = threadIdx.x; unsigned bx_ = vcu; size_t zoff_ = 0;
        asm volatile("" : "+v"(tid_)); asm volatile("" : "+s"(bx_)); asm volatile("" : "+s"(zoff_));
        unsigned char* ws = a.ws + zoff_; float* outp = a.out + zoff_;
        Ctx c;
        c.in = a.in; c.ws = ws; c.X = outp; c.lds = (LAS unsigned char*)lds_raw;
        c.tid = tid_; c.lane = c.tid & 63; c.wave = __builtin_amdgcn_readfirstlane(c.tid >> 6);
        c.G = gridDim.x; c.gtid = bx_ * 512 + c.tid; c.NT = c.G * 512; c.gw = bx_ * 8 + c.wave; c.NGW = c.G * 8;
        bf16_t* XB = (bf16_t*)(ws + WS_XB);
        bf16_t* XBA = (bf16_t*)outp;
        float* ssq1 = (float*)(ws + WS_SSQ1); float* ssq2 = (float*)(ws + WS_SSQ2); float* ssq3 = (float*)(ws + WS_SSQ3);
        if (ph == 0) prologue(c);
        else if (ph == 1 + NSUB * DEPTH) final_phase(c);
        else {
            const int l = (ph - 1) / NSUB, s = (ph - 1) % NSUB;
            pg8::StaticOrder S;
            switch (s) {
#if !defined(ONLY) || ONLY == 0
            case 0: {
                pg8::Gemm g{XBA, (const bf16_t*)(ws + WS_WIN)}; S.init(M, WIN, c.G, bx_);
                pg8::EpiWin E{(bf16_t*)(ws + WS_RX), (bf16_t*)(ws + WS_CX), ssq1, (const LAS float*)(c.lds + SSQ_TAB_OFF)};
                pg8::gemm_phase<DM, DM, DM, 0, KREP_WIN>(c.lds, c.tid, g, S, E); } break;
#endif
#if !defined(ONLY) || ONLY == 1
            case 1: conv4_phase(c, l); conv_late(c, l); break;
#endif
#if !defined(ONLY) || ONLY == 2
            case 2: {
                pg8::Gemm g{(const bf16_t*)(ws + WS_XC), (const bf16_t*)(ws + WS_WG)}; S.init(M, 2048, c.G, bx_);
                pg8::EpiGate E{(bf16_t*)(ws + WS_RX), (bf16_t*)(ws + WS_U), a.in[7] + l * DM, a.in[9] + l * DM};
                pg8::gemm_phase<256, DM, 256, 256>(c.lds, c.tid, g, S, E); } break;
#endif
#if !defined(ONLY) || ONLY == 3
            case 3: scan_local(c, l); if (l + 1 < DEPTH) conv_early(c, l + 1); break;
#endif
#if !defined(ONLY) || ONLY == 5
            case 4: merge_phase(c, l, bx_); break;
#endif
#if !defined(ONLY) || ONLY == 6
            case 5: {
                { pg8::Gemm g{(const bf16_t*)(ws + WS_XC), (const bf16_t*)(ws + WS_WOUT)}; S.init(M, DM, c.G, bx_);
                  pg8::EpiRes E{XBA, XB, ssq2};
                  pg8::gemm_phase<DM, DM, DM, 0>(c.lds, c.tid, g, S, E); }
                { int tid2 = c.tid; asm volatile("" : "+v"(tid2));
                  pg8::Gemm g{(const bf16_t*)(ws + WS_PB), (const bf16_t*)(ws + WS_WPLE)}; S.init(M, DM, c.G, bx_);
                  pg8::EpiBf E{(bf16_t*)(ws + WS_U), DM};
                  pg8::gemm_phase<PLE, PLE, PLE, 0>(c.lds, tid2, g, S, E); } } break;
#endif
#if !defined(ONLY) || ONLY == 7
            case 6: {
                pg8::Gemm g{XB, (const bf16_t*)(ws + WS_WGU)}; S.init(M, 2 * DFF, c.G, bx_);
                pg8::EpiSwi E{(bf16_t*)(ws + WS_ACT), ssq2, (const LAS float*)(c.lds + SSQ_TAB_OFF)};
                pg8::gemm_phase<DM, DM, DM, 0>(c.lds, c.tid, g, S, E); } break;
#endif
#if !defined(ONLY) || ONLY == 8
            case 7: {
                pg8::Gemm g{(const bf16_t*)(ws + WS_ACT), (const bf16_t*)(ws + WS_WDN)}; S.init(M, DM, c.G, bx_);
                pg8::EpiRes E{XB, XB, ssq3};
                pg8::gemm_phase<DFF, DFF, DFF, 0>(c.lds, c.tid, g, S, E); } break;
#endif
#if !defined(ONLY) || ONLY == 9
            default: {
                pg8::Gemm g{XB, (const bf16_t*)(ws + WS_WPG)}; S.init(M, DM, c.G, bx_);
                pg8::EpiPle E{XB, (l == DEPTH - 1) ? (bf16_t*)(ws + WS_XC) : XBA, (const bf16_t*)(ws + WS_U), ssq3, ssq1, (const LAS float*)(c.lds + SSQ_TAB_OFF)};
                pg8::gemm_phase<DM, DM, DM, 0>(c.lds, c.tid, g, S, E); } break;
#endif
            }
        }
        if (ph + 1 < a.ph_hi) { if (a.ph_hi < 0) grid.sync(); else xcd_barrier(xbar); }
        for (int xs = 0; xs < EXTRA_SYNCS; ++xs) xcd_barrier(xbar);
        if (DUPMASK != 0 && ph >= 1 && ph <= NSUB * DEPTH && ((DUPMASK >> ((ph - 1) % NSUB)) & 1) && !dup_done) { dup_done = true; --ph; } else dup_done = false;
    }
}

extern "C" void kernel_launch(void* const* d_in, const int* in_sizes, int n_in, void* d_out, int out_size, void* d_ws, size_t ws_size, hipStream_t stream) {
    static int grid = 0;
    if (grid == 0) {
        if (n_in != 20 || out_size != M * DM || ws_size < WS_END) { fprintf(stderr, "kernel_launch: unexpected sizes n_in %d out %d ws %zu\n", n_in, out_size, ws_size); grid = -1; return; }
        int dev = 0, cus = 0, per_cu = 0;
        hipGetDevice(&dev); hipDeviceGetAttribute(&cus, hipDeviceAttributeMultiprocessorCount, dev);
        if (hipFuncSetAttribute((const void*)fwd_mega, hipFuncAttributeMaxDynamicSharedMemorySize, LDS_BYTES) != hipSuccess) { fprintf(stderr, "kernel_launch: hipFuncSetAttribute failed\n"); grid = -1; return; }
        if (hipOccupancyMaxActiveBlocksPerMultiprocessor(&per_cu, (const void*)fwd_mega, 512, LDS_BYTES) != hipSuccess || per_cu < 1) { fprintf(stderr, "kernel_launch: occupancy query gives %d\n", per_cu); per_cu = 1; }
        (void)hipGetLastError();
        grid = cus * 1;
    }
    if (grid < 0) return;
    if (hipMemsetAsync((char*)d_ws + WS_BAR, 0, BAR_BYTES, stream) != hipSuccess) { fprintf(stderr, "kernel_launch: memset failed\n"); return; }
    Args a{};
    for (int i = 0; i < 20; ++i) a.in[i] = (const float*)d_in[i];
    a.out = (float*)d_out; a.ws = (unsigned char*)d_ws; a.ph_lo = 0; a.ph_hi = 2 + NSUB * DEPTH;
    void* args[] = {&a};
    hipError_t e = hipLaunchCooperativeKernel((const void*)fwd_mega, dim3(grid), dim3(512), args, LDS_BYTES, stream);
    if (e != hipSuccess) fprintf(stderr, "cooperative launch failed: %s (grid %d)\n", hipGetErrorString(e), grid);
}
```

```cpp
#include <hip/hip_runtime.h>
#include <hip/hip_cooperative_groups.h>
#include <cstdio>
#include <cstdint>
namespace cg = cooperative_groups;

#define LAS __attribute__((address_space(3)))
typedef unsigned short bf16_t;
typedef short bf16x8 __attribute__((ext_vector_type(8)));
typedef float f32x4 __attribute__((ext_vector_type(4)));
typedef float f32x2 __attribute__((ext_vector_type(2)));
typedef unsigned u32x4 __attribute__((ext_vector_type(4)));
typedef unsigned u32x2 __attribute__((ext_vector_type(2)));

constexpr int DM = 1024, BATCH = 4, SEQ = 8192, DEPTH = 4, M = BATCH * SEQ;
constexpr int DFF = 2816, WIN = 7168, PLE = 256;
constexpr int LCH = 64, NCHUNK = M / LCH;
constexpr float EPS = 1e-6f;

constexpr size_t MiB = 1u << 20;
constexpr size_t WS_SSQ1 = 0 * MiB, WS_SSQ2 = 2 * MiB, WS_SSQ3 = 4 * MiB, WS_PS = 6 * MiB, WS_HS = 8 * MiB, WS_CARRY = 10 * MiB, WS_SP8 = 12 * MiB;
constexpr size_t WS_BAR = 13 * MiB, BAR_BYTES = 16384;
constexpr size_t WS_WIN = 16 * MiB;
constexpr size_t WS_WG = 30 * MiB;
constexpr size_t WS_WOUT = 32 * MiB;
constexpr size_t WS_WGU = 34 * MiB;
constexpr size_t WS_WDN = 45 * MiB;
constexpr size_t WS_WPG = 51 * MiB;
constexpr size_t WS_WPLE = 53 * MiB;
constexpr size_t WS_PB = 56 * MiB;
constexpr size_t WS_XB = 72 * MiB;
constexpr size_t WS_RX = 136 * MiB;
constexpr size_t WS_CX = 200 * MiB;
constexpr size_t WS_GY = 264 * MiB;
constexpr size_t WS_GB = 328 * MiB;
constexpr size_t WS_XC = 392 * MiB;
constexpr size_t WS_U = 456 * MiB;
constexpr size_t WS_ACT = 136 * MiB;
constexpr size_t WS_END = 520 * MiB;
static_assert(WS_GY == WS_CX + 64 * MiB && WS_GB == WS_GY + 64 * MiB, "CX | GY | GB consecutive");

constexpr int NSUB = 8;
constexpr int RING_BYTES = 131072;
constexpr int SSQ_TAB_OFF = RING_BYTES + 1024;
constexpr int LDS_BYTES = SSQ_TAB_OFF + 16384 + 1024;

__device__ __forceinline__ unsigned cvt_pk_bf16(float lo, float hi) { unsigned r; asm volatile("v_cvt_pk_bf16_f32 %0, %1, %2" : "=v"(r) : "v"(lo), "v"(hi)); return r; }
__device__ __forceinline__ u32x4 pack8(const float (&f)[8]) { u32x4 w; w.x = cvt_pk_bf16(f[0], f[1]); w.y = cvt_pk_bf16(f[2], f[3]); w.z = cvt_pk_bf16(f[4], f[5]); w.w = cvt_pk_bf16(f[6], f[7]); return w; }
__device__ __forceinline__ void unpack8(const u32x4 w, float (&f)[8]) {
    f[0] = __uint_as_float(w.x << 16); f[1] = __uint_as_float(w.x & 0xffff0000u); f[2] = __uint_as_float(w.y << 16); f[3] = __uint_as_float(w.y & 0xffff0000u);
    f[4] = __uint_as_float(w.z << 16); f[5] = __uint_as_float(w.z & 0xffff0000u); f[6] = __uint_as_float(w.w << 16); f[7] = __uint_as_float(w.w & 0xffff0000u); }
__device__ __forceinline__ void unpack4(const u32x2 w, float (&f)[4]) {
    f[0] = __uint_as_float(w.x << 16); f[1] = __uint_as_float(w.x & 0xffff0000u); f[2] = __uint_as_float(w.y << 16); f[3] = __uint_as_float(w.y & 0xffff0000u); }
__device__ __forceinline__ float sigm(float v) { return __builtin_amdgcn_rcpf(1.f + __expf(-v)); }
__device__ __forceinline__ float gelu_tanh(float v) { return v * sigm(1.5957691216057308f * (v + 0.044715f * v * v * v)); }
__device__ __forceinline__ float row_rstd(const float* ssq, int row) {
    const f32x4* p = (const f32x4*)(ssq + (size_t)row * 16);
    const f32x4 a = p[0], b = p[1], c = p[2], d = p[3];
    const float s = (((a.x + a.y) + (a.z + a.w)) + ((b.x + b.y) + (b.z + b.w))) + (((c.x + c.y) + (c.z + c.w)) + ((d.x + d.y) + (d.z + d.w)));
    return rsqrtf(s * (1.0f / DM) + EPS);
}
__device__ __forceinline__ float row_rstd_q(const float* ssq, int row, int fq) {
    const f32x4 a = *(const f32x4*)(ssq + (size_t)row * 16 + fq * 4);
    float s = (a.x + a.y) + (a.z + a.w); s += __shfl_xor(s, 16); s += __shfl_xor(s, 32);
    return rsqrtf(s * (1.0f / DM) + EPS);
}
__device__ __forceinline__ f32x4 exp2n4(f32x4 x) {
    const f32x4 a = x * (-1.4426950408889634f); f32x4 e; e.x = __builtin_amdgcn_exp2f(a.x); e.y = __builtin_amdgcn_exp2f(a.y); e.z = __builtin_amdgcn_exp2f(a.z); e.w = __builtin_amdgcn_exp2f(a.w); return e; }
__device__ __forceinline__ f32x4 rcp4(f32x4 d) { f32x4 r; r.x = __builtin_amdgcn_rcpf(d.x); r.y = __builtin_amdgcn_rcpf(d.y); r.z = __builtin_amdgcn_rcpf(d.z); r.w = __builtin_amdgcn_rcpf(d.w); return r; }
__device__ __forceinline__ f32x4 sigm4(f32x4 x) { return rcp4(exp2n4(x) + 1.0f); }
__device__ __forceinline__ u32x2 pack4(f32x4 v) { u32x2 w; w.x = cvt_pk_bf16(v.x, v.y); w.y = cvt_pk_bf16(v.z, v.w); return w; }
__device__ __forceinline__ f32x4 unpack4v(const u32x2 w) { return (f32x4){__uint_as_float(w.x << 16), __uint_as_float(w.x & 0xffff0000u), __uint_as_float(w.y << 16), __uint_as_float(w.y & 0xffff0000u)}; }
__device__ __forceinline__ float row_rstd_lds(const LAS float* tab, int rl, int fq) {
    const f32x4 a = *(const LAS f32x4*)(tab + rl * 16 + fq * 4);
    float s = (a.x + a.y) + (a.z + a.w); s += __shfl_xor(s, 16); s += __shfl_xor(s, 32);
    return rsqrtf(s * (1.0f / DM) + EPS);
}
#define EPI_FENCE() asm volatile("" ::: "memory")
#define LDS_WAIT() asm volatile("s_waitcnt lgkmcnt(0)" ::: "memory")

namespace pg8 {
constexpr int BM = 256, BK = 64, HALF = 128, HTB = HALF * BK * 2, NXCD = 8, WGM = 8;
__host__ __device__ __forceinline__ int lds_byte(int r, int c) { const int st = (r >> 4) * 2 + (c >> 5), rr = r & 15, cc = c & 31, ob = rr * 64 + cc * 2; return st * 1024 + (ob ^ (((ob >> 9) & 1) << 5)); }
__host__ __device__ __forceinline__ void stage_rc(int b, int& R, int& C) { const int st = b / 1024, sb = b % 1024, swz = sb ^ (((sb >> 9) & 1) << 5); R = (st >> 1) * 16 + swz / 64; C = (st & 1) * 32 + (swz % 64) / 2; }
__host__ __device__ __forceinline__ int perm32(int rho) { const int n = rho >> 4, i = rho & 15; return 8 * (i >> 2) + 4 * n + (i & 3); }

struct Unit { int pm, pn; };
struct Gemm { const bf16_t* A; const bf16_t* Bt; };

struct StaticOrder {
    int nM, nN, nwg, G, c;
    __device__ void init(int M_, int N_, int G_, int c_) { nM = M_ / BM; nN = N_ / BM; nwg = nM * nN; G = G_; c = c_; }
    __device__ bool next(int i, Unit& u) const {
        const long L = (long)i * G + c; if (L >= nwg) return false;
        int wgid = (int)L; { const int q = nwg / NXCD, r = nwg % NXCD, xcd = wgid % NXCD, off = wgid / NXCD; wgid = (xcd < r ? xcd * (q + 1) : r * (q + 1) + (xcd - r) * q) + off; }
        const int nig = WGM * nN, gid = wgid / nig, fm = gid * WGM, gsz = (nM - fm) < WGM ? (nM - fm) : WGM;
        u.pm = fm + ((wgid % nig) % gsz); u.pn = (wgid % nig) / gsz; return true;
    }
};

typedef f32x4 Acc[2][2][4][2];

struct EpiWin {
    static constexpr bool PREF = true;
    bf16_t* RX; bf16_t* CX; const float* ssq; const LAS float* tab;
    __device__ __forceinline__ void operator()(const Acc& acc, const Unit& u, int wr, int wc, int fr, int fq) const {
        const int row0 = u.pm * BM + wr * 64 + fr;
        float rsv[2][4];
#pragma unroll
        for (int ai = 0; ai < 2; ++ai)
#pragma unroll
            for (int m = 0; m < 4; ++m) rsv[ai][m] = row_rstd_lds(tab, wr * 64 + fr + ai * HALF + m * 16, fq);
        EPI_FENCE();
        if (u.pn < 4) {
#pragma unroll
            for (int ai = 0; ai < 2; ++ai)
#pragma unroll
                for (int m = 0; m < 4; ++m) { const int row = row0 + ai * HALF + m * 16; const float rs = rsv[ai][m];
                    bf16_t* rp = RX + (size_t)row * DM + u.pn * BM + wc * 32 + 8 * fq;
#pragma unroll
                    for (int bj = 0; bj < 2; ++bj) { const u32x2 p0 = pack4(acc[ai][bj][m][0] * rs), p1 = pack4(acc[ai][bj][m][1] * rs);
                        *(u32x4*)(rp + bj * HALF) = (u32x4){p0.x, p0.y, p1.x, p1.y}; } EPI_FENCE(); }
        } else {
            const int q = (u.pn - 4) >> 3, j = (u.pn - 4) & 7;
            bf16_t* dst = CX + (size_t)q * (size_t)(32u << 20) + j * 128 + wc * 32 + 8 * fq;
#pragma unroll
            for (int ai = 0; ai < 2; ++ai)
#pragma unroll
                for (int m = 0; m < 4; ++m) { const int row = row0 + ai * HALF + m * 16; const float rs = rsv[ai][m];
                    u32x4 w;
#pragma unroll
                    for (int n = 0; n < 2; ++n) { const f32x4 v0 = acc[ai][0][m][n] * rs, v1 = acc[ai][1][m][n] * rs; f32x4 o;
                        if (q == 0) o = v0 * v1;
                        else if (q == 1) { const f32x4 t = (v0 * v0 * 0.044715f + 1.0f) * v0 * 1.5957691216057308f;
                            o = v0 * rcp4((exp2n4(t) + 1.0f) * (exp2n4(v1) + 1.0f)); }
                        else o = v0 * sigm4(v1);
                        const u32x2 p = pack4(o); if (n == 0) { w.x = p.x; w.y = p.y; } else { w.z = p.x; w.w = p.y; } }
                    *(u32x4*)(dst + (size_t)row * DM) = w; EPI_FENCE(); }
        }
    }
};
struct EpiGate {
    static constexpr bool PREF = false;
    bf16_t* PR; bf16_t* PI; const float* br; const float* bi;
    __device__ __forceinline__ void operator()(const Acc& acc, const Unit& u, int wr, int wc, int fr, int fq) const {
        const int row0 = u.pm * BM + wr * 64 + fr;
        const int c0 = (u.pn >> 1) * 256 + (u.pn & 1) * 128 + wc * 32 + 8 * fq;
        const f32x4 br0 = *(const f32x4*)(br + c0), br1 = *(const f32x4*)(br + c0 + 4), bi0 = *(const f32x4*)(bi + c0), bi1 = *(const f32x4*)(bi + c0 + 4);
#pragma unroll
        for (int ai = 0; ai < 2; ++ai)
#pragma unroll
            for (int m = 0; m < 4; ++m) { const int row = row0 + ai * HALF + m * 16; const unsigned off = (unsigned)row * DM + c0;
                const u32x2 r0 = pack4(acc[ai][0][m][0] + br0), r1 = pack4(acc[ai][0][m][1] + br1), i0 = pack4(acc[ai][1][m][0] + bi0), i1 = pack4(acc[ai][1][m][1] + bi1);
                *(u32x4*)(PR + off) = (u32x4){r0.x, r0.y, r1.x, r1.y}; *(u32x4*)(PI + off) = (u32x4){i0.x, i0.y, i1.x, i1.y}; EPI_FENCE(); }
    }
};
template <int N> __device__ __forceinline__ float dpp_row_shr(float v, float ident) {
    return __int_as_float(__builtin_amdgcn_update_dpp(__float_as_int(ident), __float_as_int(v), 0x110 | N, 0xf, 0xf, false)); }
template <int N> __device__ __forceinline__ void scan_step(f32x4& a, f32x4& uu) {
#pragma unroll
    for (int e = 0; e < 4; ++e) { const float ap = dpp_row_shr<N>(a[e], 1.0f), up = dpp_row_shr<N>(uu[e], 0.0f); uu[e] = a[e] * up + uu[e]; a[e] = a[e] * ap; } }
struct EpiGateScan {
    static constexpr bool PREF = false;
    const bf16_t* XC; bf16_t* CP; bf16_t* HL; float* PS; float* HS; const float* br; const float* bi; const float* sp8;
    __device__ __forceinline__ void operator()(const Acc& acc, const Unit& u, int wr, int wc, int fr, int fq) const {
        const int row0 = u.pm * BM + wr * 64 + fr;
        const int c0 = (u.pn >> 1) * 256 + (u.pn & 1) * 128 + wc * 32 + 8 * fq;
        const int baddr = ((fq * 16) | 15) * 4;
        f32x4 b_r[2], b_i[2], sp[2];
#pragma unroll
        for (int nh = 0; nh < 2; ++nh) { b_r[nh] = *(const f32x4*)(br + c0 + 4 * nh); b_i[nh] = *(const f32x4*)(bi + c0 + 4 * nh); sp[nh] = *(const f32x4*)(sp8 + c0 + 4 * nh); }
#pragma unroll
        for (int ai = 0; ai < 2; ++ai) {
            u32x4 xw[4];
#pragma unroll
            for (int m = 0; m < 4; ++m) xw[m] = *(const u32x4*)(XC + (unsigned)(row0 + ai * HALF + m * 16) * DM + c0);
            EPI_FENCE();
            f32x4 Ac[2], Hc[2], cp[2], hl[2];
#pragma unroll
            for (int nh = 0; nh < 2; ++nh) { Ac[nh] = (f32x4){1.f, 1.f, 1.f, 1.f}; Hc[nh] = (f32x4){0.f, 0.f, 0.f, 0.f}; }
#pragma unroll
            for (int m = 0; m < 4; ++m) { const unsigned off = (unsigned)(row0 + ai * HALF + m * 16) * DM + c0;
#pragma unroll
                for (int nh = 0; nh < 2; ++nh) {
                    const f32x4 xc = nh == 0 ? unpack4v((u32x2){xw[m].x, xw[m].y}) : unpack4v((u32x2){xw[m].z, xw[m].w});
                    const f32x4 r = sigm4(acc[ai][0][m][nh] + b_r[nh]), ig = sigm4(acc[ai][1][m][nh] + b_i[nh]);
                    const f32x4 lg = -(r * sp[nh]), x2 = lg + lg;
                    f32x4 em = x2 * (x2 * (x2 * (x2 * (x2 * (x2 * 0.0013888889f + 0.0083333338f) + 0.041666668f) + 0.16666667f) + 0.5f) + 1.0f);
                    if (__builtin_amdgcn_ballot_w64((x2.x <= -0.25f) | (x2.y <= -0.25f) | (x2.z <= -0.25f) | (x2.w <= -0.25f)) != 0ull) {
#pragma unroll
                        for (int e = 0; e < 4; ++e) if (x2[e] <= -0.25f) em[e] = __expf(x2[e]) - 1.f; }
                    f32x4 s; s.x = __builtin_amdgcn_sqrtf(-em.x); s.y = __builtin_amdgcn_sqrtf(-em.y); s.z = __builtin_amdgcn_sqrtf(-em.z); s.w = __builtin_amdgcn_sqrtf(-em.w);
                    f32x4 a = exp2n4(-lg), uu = s * ig * xc;
                    scan_step<1>(a, uu); scan_step<2>(a, uu); scan_step<4>(a, uu); scan_step<8>(a, uu);
                    cp[nh] = Ac[nh] * a; hl[nh] = uu + a * Hc[nh];
                    if (m < 3) {
#pragma unroll
                        for (int e = 0; e < 4; ++e) { Ac[nh][e] = __int_as_float(__builtin_amdgcn_ds_bpermute(baddr, __float_as_int(cp[nh][e]))); Hc[nh][e] = __int_as_float(__builtin_amdgcn_ds_bpermute(baddr, __float_as_int(hl[nh][e]))); } }
                }
                const u32x2 q0 = pack4(cp[0]), q1 = pack4(cp[1]), h0 = pack4(hl[0]), h1 = pack4(hl[1]);
                *(u32x4*)(CP + off) = (u32x4){q0.x, q0.y, q1.x, q1.y}; *(u32x4*)(HL + off) = (u32x4){h0.x, h0.y, h1.x, h1.y}; }
            if (fr == 15) { const size_t t = (size_t)(u.pm * 4 + ai * 2 + wr) * DM + c0;
                *(f32x4*)(PS + t) = cp[0]; *(f32x4*)(PS + t + 4) = cp[1]; *(f32x4*)(HS + t) = hl[0]; *(f32x4*)(HS + t + 4) = hl[1]; }
            EPI_FENCE();
        }
    }
};
struct EpiRes {
    static constexpr bool PREF = false;
    const bf16_t* xin; bf16_t* xout; float* ssq;
    __device__ __forceinline__ void operator()(const Acc& acc, const Unit& u, int wr, int wc, int fr, int fq) const {
        const int row0 = u.pm * BM + wr * 64 + fr; const int col0 = u.pn * BM + wc * 32 + 8 * fq;
#pragma unroll
        for (int ai = 0; ai < 2; ++ai) {
            u32x4 xw[4][2];
#pragma unroll
            for (int m = 0; m < 4; ++m)
#pragma unroll
                for (int bj = 0; bj < 2; ++bj) xw[m][bj] = *(const u32x4*)(xin + (unsigned)(row0 + ai * HALF + m * 16) * DM + col0 + bj * HALF);
            EPI_FENCE();
#pragma unroll
            for (int m = 0; m < 4; ++m) { const int row = row0 + ai * HALF + m * 16; float ss = 0.f;
#pragma unroll
                for (int bj = 0; bj < 2; ++bj) { const unsigned off = (unsigned)row * DM + col0 + bj * HALF;
                    const f32x4 v0 = unpack4v((u32x2){xw[m][bj].x, xw[m][bj].y}) + acc[ai][bj][m][0], v1 = unpack4v((u32x2){xw[m][bj].z, xw[m][bj].w}) + acc[ai][bj][m][1];
                    const f32x4 q = v0 * v0 + v1 * v1; ss += (q.x + q.y) + (q.z + q.w);
                    const u32x2 p0 = pack4(v0), p1 = pack4(v1); *(u32x4*)(xout + off) = (u32x4){p0.x, p0.y, p1.x, p1.y}; }
                ss += __shfl_xor(ss, 16); ss += __shfl_xor(ss, 32);
                if (fq == 0) ssq[(size_t)row * 16 + u.pn * 4 + wc] = ss; }
            EPI_FENCE();
        }
    }
};
struct EpiPle {
    static constexpr bool PREF = true;
    const bf16_t* xin; bf16_t* xout; const bf16_t* E; const float* ssq; float* ssq_out; const LAS float* tab;
    __device__ __forceinline__ void operator()(const Acc& acc, const Unit& u, int wr, int wc, int fr, int fq) const {
        const int row0 = u.pm * BM + wr * 64 + fr; const int col0 = u.pn * BM + wc * 32 + 8 * fq;
        float rsv[2][4];
#pragma unroll
        for (int ai = 0; ai < 2; ++ai)
#pragma unroll
            for (int m = 0; m < 4; ++m) rsv[ai][m] = row_rstd_lds(tab, wr * 64 + fr + ai * HALF + m * 16, fq);
        EPI_FENCE();
#pragma unroll
        for (int ai = 0; ai < 2; ++ai)
#pragma unroll
            for (int mh = 0; mh < 4; mh += 2) {
                u32x4 xw[2][2], ew[2][2];
#pragma unroll
                for (int m = 0; m < 2; ++m)
#pragma unroll
                    for (int bj = 0; bj < 2; ++bj) { const unsigned off = (unsigned)(row0 + ai * HALF + (mh + m) * 16) * DM + col0 + bj * HALF; xw[m][bj] = *(const u32x4*)(xin + off); ew[m][bj] = *(const u32x4*)(E + off); }
                EPI_FENCE();
#pragma unroll
                for (int m = 0; m < 2; ++m) { const int row = row0 + ai * HALF + (mh + m) * 16; const float rs = rsv[ai][mh + m]; float ss = 0.f;
#pragma unroll
                    for (int bj = 0; bj < 2; ++bj) { const unsigned off = (unsigned)row * DM + col0 + bj * HALF;
                        const f32x4 v0 = unpack4v((u32x2){xw[m][bj].x, xw[m][bj].y}) + sigm4(acc[ai][bj][mh + m][0] * rs) * unpack4v((u32x2){ew[m][bj].x, ew[m][bj].y});
                        const f32x4 v1 = unpack4v((u32x2){xw[m][bj].z, xw[m][bj].w}) + sigm4(acc[ai][bj][mh + m][1] * rs) * unpack4v((u32x2){ew[m][bj].z, ew[m][bj].w});
                        const f32x4 q = v0 * v0 + v1 * v1; ss += (q.x + q.y) + (q.z + q.w);
                        const u32x2 p0 = pack4(v0), p1 = pack4(v1); *(u32x4*)(xout + off) = (u32x4){p0.x, p0.y, p1.x, p1.y}; }
                    ss += __shfl_xor(ss, 16); ss += __shfl_xor(ss, 32);
                    if (fq == 0) ssq_out[(size_t)row * 16 + u.pn * 4 + wc] = ss; }
                EPI_FENCE();
            }
    }
};
struct EpiSwi {
    static constexpr bool PREF = true;
    bf16_t* ACT; const float* ssq; const LAS float* tab;
    __device__ __forceinline__ void operator()(const Acc& acc, const Unit& u, int wr, int wc, int fr, int fq) const {
        const int row0 = u.pm * BM + wr * 64 + fr; const int col0 = u.pn * 128 + wc * 32 + 8 * fq;
        float rsv[2][4];
#pragma unroll
        for (int ai = 0; ai < 2; ++ai)
#pragma unroll
            for (int m = 0; m < 4; ++m) rsv[ai][m] = row_rstd_lds(tab, wr * 64 + fr + ai * HALF + m * 16, fq);
        EPI_FENCE();
#pragma unroll
        for (int ai = 0; ai < 2; ++ai)
#pragma unroll
            for (int m = 0; m < 4; ++m) { const int row = row0 + ai * HALF + m * 16; const float rs = rsv[ai][m];
                const f32x4 g0 = acc[ai][0][m][0] * rs, g1 = acc[ai][0][m][1] * rs;
                const u32x2 p0 = pack4(g0 * sigm4(g0) * (acc[ai][1][m][0] * rs)), p1 = pack4(g1 * sigm4(g1) * (acc[ai][1][m][1] * rs));
                *(u32x4*)(ACT + (size_t)row * DFF + col0) = (u32x4){p0.x, p0.y, p1.x, p1.y}; EPI_FENCE(); }
    }
};
struct EpiBf {
    static constexpr bool PREF = false;
    bf16_t* O; int ldc;
    __device__ __forceinline__ void operator()(const Acc& acc, const Unit& u, int wr, int wc, int fr, int fq) const {
        const int row0 = u.pm * BM + wr * 64 + fr; const int col0 = u.pn * BM + wc * 32 + 8 * fq;
#pragma unroll
        for (int ai = 0; ai < 2; ++ai)
#pragma unroll
            for (int m = 0; m < 4; ++m) { const int row = row0 + ai * HALF + m * 16;
#pragma unroll
                for (int bj = 0; bj < 2; ++bj) { float v[8];
#pragma unroll
                    for (int e = 0; e < 8; ++e) v[e] = acc[ai][bj][m][e >> 2][e & 3];
                    *(u32x4*)(O + (size_t)row * ldc + col0 + bj * HALF) = pack8(v); } EPI_FENCE(); }
    }
};

template <int K, int LDA, int LDB, int ACS, int KREP = 1, class Epi>
__device__ __forceinline__ void gemm_phase(LAS unsigned char* lds, const int tid, const Gemm g, const StaticOrder& S, const Epi& E) {
    const int wid = __builtin_amdgcn_readfirstlane(tid >> 6), lane = tid & 63, wr = wid >> 2, wc = wid & 3, fr = lane & 15, fq = lane >> 4;
    constexpr int nt = K / BK;
    unsigned voffA[2], voffB[2];
#pragma unroll
    for (int i = 0; i < 2; ++i) { int R, C; stage_rc(tid * 16 + i * 8192, R, C); const int Rb = (R & ~31) + perm32(R & 31);
        voffA[i] = (unsigned)(R * LDA + C) * 2u; voffB[i] = (unsigned)(Rb * LDB + C) * 2u; }
    constexpr size_t kstep = (size_t)(BK * 2);
    constexpr size_t hstepA = (size_t)HALF * LDA * 2, hstepB = (size_t)HALF * LDB * 2;
    constexpr size_t tstepA = 2 * hstepA, tstepB = 2 * hstepB;
    const unsigned ldsw = (unsigned)wid * 1024u;
    const int aoff = lds_byte(wr * 64 + fr, fq * 8), boff = lds_byte(wc * 32 + fr, fq * 8);
#define PG8_SA(b, h) (((b) * 2 + (h)) * HTB)
#define PG8_SB(b, h) ((4 + (b) * 2 + (h)) * HTB)
#define PG8_STAGE(bufoff, gbase, voff) do { _Pragma("unroll") for (int _i = 0; _i < 2; ++_i) \
        __builtin_amdgcn_global_load_lds((const unsigned*)((const char*)(gbase) + (voff)[_i]), (LAS unsigned*)(lds + (bufoff) + ldsw + _i * 8192), 16, 0, 0); } while (0)
#define PG8_LDA(dst, b, h) do { _Pragma("unroll") for (int m = 0; m < 4; ++m) _Pragma("unroll") for (int k = 0; k < 2; ++k) dst[m][k] = *(const LAS bf16x8*)(lds + PG8_SA(b, h) + aoff + m * 2048 + k * 1024); } while (0)
#define PG8_LDB(dst, b, h) do { _Pragma("unroll") for (int n = 0; n < 2; ++n) _Pragma("unroll") for (int k = 0; k < 2; ++k) dst[n][k] = *(const LAS bf16x8*)(lds + PG8_SB(b, h) + boff + n * 2048 + k * 1024); } while (0)
#define PG8_MMA(ai, bj, At, Bt) do { __builtin_amdgcn_s_setprio(1); _Pragma("unroll") for (int m = 0; m < 4; ++m) _Pragma("unroll") for (int n = 0; n < 2; ++n) _Pragma("unroll") for (int k = 0; k < 2; ++k) \
        acc[ai][bj][m][n] = __builtin_amdgcn_mfma_f32_16x16x32_bf16(Bt[n][k], At[m][k], acc[ai][bj][m][n], 0, 0, 0); __builtin_amdgcn_s_setprio(0); } while (0)
#define PG8_WAIT_V(n) asm volatile("s_waitcnt vmcnt(" #n ")" ::: "memory")
#define PG8_WAIT_L(n) asm volatile("s_waitcnt lgkmcnt(" #n ")" ::: "memory")
#define PG8_BAR __builtin_amdgcn_s_barrier()
#define PG8_SCHED __builtin_amdgcn_sched_barrier(0)
    Unit cur, nxt; int ui = 0;
    if (!S.next(0, cur)) return;
    Acc acc;
#pragma unroll
    for (int a = 0; a < 2; ++a)
#pragma unroll
        for (int b = 0; b < 2; ++b)
#pragma unroll
            for (int m = 0; m < 4; ++m)
#pragma unroll
                for (int n = 0; n < 2; ++n) acc[a][b][m][n] = (f32x4){0.f, 0.f, 0.f, 0.f};
    bf16x8 At[4][2], B0[2][2], B1[2][2];
    const char* cA = (const char*)g.A + (size_t)cur.pm * tstepA + (size_t)((cur.pn >> 1) * ACS) * 2; const char* cB = (const char*)g.Bt + (size_t)cur.pn * tstepB;
    PG8_STAGE(PG8_SB(0, 0), cB, voffB); PG8_STAGE(PG8_SB(0, 1), cB + hstepB, voffB); PG8_STAGE(PG8_SA(0, 0), cA, voffA); PG8_STAGE(PG8_SA(0, 1), cA + hstepA, voffA);
    if (wr == 1) PG8_BAR;
    PG8_WAIT_V(2); PG8_BAR;
    PG8_STAGE(PG8_SB(1, 0), cB + kstep, voffB); PG8_STAGE(PG8_SA(1, 0), cA + kstep, voffA); PG8_STAGE(PG8_SB(1, 1), cB + hstepB + kstep, voffB);
    PG8_WAIT_V(6); PG8_BAR;
    for (;;) {
        const bool has_next = S.next(ui + 1, nxt);
        const char* nA = has_next ? (const char*)g.A + (size_t)nxt.pm * tstepA + (size_t)((nxt.pn >> 1) * ACS) * 2 : cA; const char* nB = has_next ? (const char*)g.Bt + (size_t)nxt.pn * tstepB : cB;
#pragma unroll 1
        for (int tt = 0; tt < nt * KREP; tt += 2) {
            const int t = (KREP == 1) ? tt : tt % nt;
            const bool last = (t == nt - 2), lastrep = (KREP == 1) || (tt == nt * KREP - 2);
            const char* a1 = cA + (size_t)(t + 1) * kstep;
            const char* a2 = last ? (lastrep ? nA : cA) : cA + (size_t)(t + 2) * kstep; const char* b2 = last ? (lastrep ? nB : cB) : cB + (size_t)(t + 2) * kstep;
            const char* a3 = a2 + kstep; const char* b3 = b2 + kstep;
            PG8_LDB(B0, 0, 0); PG8_LDB(B1, 0, 1); PG8_SCHED; PG8_LDA(At, 0, 0); PG8_STAGE(PG8_SA(1, 1), a1 + hstepA, voffA);
            PG8_WAIT_V(8); PG8_WAIT_L(0); PG8_BAR; PG8_MMA(0, 0, At, B0); PG8_MMA(0, 1, At, B1); PG8_BAR; PG8_SCHED;
            if constexpr (Epi::PREF) { if (tt == 0) {
#pragma unroll
                for (int q_ = 0; q_ < 2; ++q_) { const int p_ = 2 * wc + q_, rl_ = (p_ >> 2) * HALF + wr * 64 + (p_ & 3) * 16;
                    __builtin_amdgcn_global_load_lds((const unsigned*)(E.ssq + ((size_t)cur.pm * BM + rl_) * 16 + lane * 4), (LAS unsigned*)(lds + SSQ_TAB_OFF + rl_ * 64), 16, 0, 0); } }
                PG8_SCHED; }
            PG8_LDA(At, 0, 1); PG8_STAGE(PG8_SB(0, 0), b2, voffB); PG8_STAGE(PG8_SB(0, 1), b2 + hstepB, voffB); PG8_STAGE(PG8_SA(0, 0), a2, voffA);
            PG8_WAIT_V(8); PG8_WAIT_L(0); PG8_BAR; PG8_MMA(1, 0, At, B0); PG8_MMA(1, 1, At, B1); PG8_BAR; PG8_SCHED;
            PG8_LDB(B0, 1, 0); PG8_LDB(B1, 1, 1); PG8_SCHED; PG8_LDA(At, 1, 0); PG8_STAGE(PG8_SA(0, 1), a2 + hstepA, voffA);
            PG8_WAIT_V(8); PG8_WAIT_L(0); PG8_BAR; PG8_MMA(0, 0, At, B0); PG8_MMA(0, 1, At, B1); PG8_BAR; PG8_SCHED;
            PG8_LDA(At, 1, 1); PG8_STAGE(PG8_SB(1, 0), b3, voffB); PG8_STAGE(PG8_SB(1, 1), b3 + hstepB, voffB); PG8_STAGE(PG8_SA(1, 0), a3, voffA);
            PG8_WAIT_V(8); PG8_WAIT_L(0); PG8_BAR; PG8_MMA(1, 0, At, B0); PG8_MMA(1, 1, At, B1); PG8_BAR; PG8_SCHED;
        }
        if (wr == 0) PG8_BAR;
        if constexpr (KREP != 1) {
#pragma unroll
            for (int a = 0; a < 2; ++a)
#pragma unroll
                for (int b = 0; b < 2; ++b)
#pragma unroll
                    for (int m = 0; m < 4; ++m)
#pragma unroll
                        for (int n = 0; n < 2; ++n) acc[a][b][m][n] = acc[a][b][m][n] * (1.0f / KREP);
        }
        E(acc, cur, wr, wc, fr, fq);
        if (!has_next) break;
#pragma unroll
        for (int a = 0; a < 2; ++a)
#pragma unroll
            for (int b = 0; b < 2; ++b)
#pragma unroll
                for (int m = 0; m < 4; ++m)
#pragma unroll
                    for (int n = 0; n < 2; ++n) acc[a][b][m][n] = (f32x4){0.f, 0.f, 0.f, 0.f};
        cur = nxt; cA = nA; cB = nB; ++ui;
        if (wr == 1) PG8_BAR;
    }
    PG8_WAIT_V(0);
    PG8_BAR;
#undef PG8_SA
#undef PG8_SB
#undef PG8_STAGE
#undef PG8_LDA
#undef PG8_LDB
#undef PG8_MMA
#undef PG8_WAIT_V
#undef PG8_WAIT_L
#undef PG8_BAR
#undef PG8_SCHED
}
}

__device__ __forceinline__ void wconv_item(const float* src, int ldsrc, const float* gain, bf16_t* dst, int lddst, LAS float* scr, int lane) {
    float wv[32];
#pragma unroll
    for (int i = 0; i < 32; ++i) { const int kk = 2 * i + (lane >> 5); wv[i] = src[(size_t)kk * ldsrc + (lane & 31)]; }
    if (gain) {
#pragma unroll
        for (int i = 0; i < 32; ++i) wv[i] *= gain[2 * i + (lane >> 5)]; }
#pragma unroll
    for (int i = 0; i < 32; ++i) { const int kk = 2 * i + (lane >> 5); scr[kk * 33 + (lane & 31)] = wv[i]; }
    LDS_WAIT(); asm volatile("" ::: "memory");
    const int c = lane & 7;
#pragma unroll
    for (int j = 0; j < 4; ++j) { const int n = (lane >> 3) + 8 * j; const LAS float* s = scr + (8 * c) * 33 + n;
        u32x4 o; o.x = cvt_pk_bf16(s[0 * 33], s[1 * 33]); o.y = cvt_pk_bf16(s[2 * 33], s[3 * 33]); o.z = cvt_pk_bf16(s[4 * 33], s[5 * 33]); o.w = cvt_pk_bf16(s[6 * 33], s[7 * 33]);
        *(u32x4*)(dst + (size_t)n * lddst + 8 * c) = o; }
    LDS_WAIT(); asm volatile("" ::: "memory");
}
__device__ __forceinline__ int win_src_col(int n0) {
    const int pn = n0 >> 8, rr = n0 & 255;
    if (pn < 4) return n0;
    const int q = (pn - 4) >> 3, j = (pn - 4) & 7, half = rr >> 7, off = rr & 127;
    int base;
    if (q == 0) base = half ? 4096 : 3072;
    else if (q == 1) base = half ? 5120 : 1024;
    else base = half ? 6144 : 2048;
    return base + 128 * j + off;
}


#define XB_TMO      128
#define XB_XCNT(j)  (256  + 64 * (j))
#define XB_XSUB(j)  (1280 + 64 * (j))
#define XB_XGEN(j)  (2304 + 64 * (j))
#define XB_TOP      3328
#define XB_TOPGEN   3392
#define XCD_BAR_WORDS 3456
#define XB_SPIN_CAP (1u << 18)
__device__ __forceinline__ unsigned xb_ld(unsigned* p)              { return __hip_atomic_load(p, __ATOMIC_RELAXED, __HIP_MEMORY_SCOPE_AGENT); }
__device__ __forceinline__ unsigned xb_add(unsigned* p, unsigned v) { return __hip_atomic_fetch_add(p, v, __ATOMIC_RELAXED, __HIP_MEMORY_SCOPE_AGENT); }
__device__ __forceinline__ unsigned xb_xcc_id() { return (unsigned)__builtin_amdgcn_s_getreg((3 << 11) | 20) & 0xFu; }
#define XB_SPIN(cond, bar) do { unsigned _sp = 0; while (cond) { __builtin_amdgcn_s_sleep(1); \
    if ((++_sp & 255u) == 0u) { if (xb_ld(&(bar)[XB_TMO])) break; if (_sp > XB_SPIN_CAP) { atomicAdd(&(bar)[XB_TMO], 1u); break; } } } } while (0)
struct XcdBarrier { unsigned* bar; unsigned x; volatile LAS unsigned* st; };
__device__ __forceinline__ XcdBarrier xcd_barrier_post(unsigned* bar, volatile LAS unsigned* st) {
    XcdBarrier b; b.bar = bar; b.x = xb_xcc_id(); b.st = st;
    if (threadIdx.x == 0) (void)xb_add(&bar[XB_XCNT(b.x)], 1u);
    return b;
}
__device__ __forceinline__ void xcd_barrier_complete(unsigned* bar, unsigned x, unsigned& nloc, unsigned& nx) {
    const unsigned G = gridDim.x * gridDim.y * gridDim.z;
    unsigned sum, cnt, mine, sp = 0u;
    for (;;) {
        sum = 0u; cnt = 0u; mine = 0u;
#pragma unroll
        for (unsigned j = 0; j < 16; ++j) { const unsigned c = xb_ld(&bar[XB_XCNT(j)]); sum += c; cnt += (c > 0u) ? 1u : 0u; mine = (j == x) ? c : mine; }
        if (sum == G) break;
        __builtin_amdgcn_s_sleep(1);
        if ((++sp & 255u) == 0u) { if (xb_ld(&bar[XB_TMO])) break; if (sp > XB_SPIN_CAP) { atomicAdd(&bar[XB_TMO], 1u); break; } }
    }
    nloc = mine > 0u ? mine : 1u; nx = cnt > 0u ? cnt : 1u;
}
__device__ __forceinline__ void xcd_barrier(const XcdBarrier& b) {
    asm volatile("s_waitcnt vmcnt(0)" ::: "memory");
    __syncthreads();
    if (threadIdx.x == 0) {
        unsigned* bar = b.bar;
        __builtin_amdgcn_s_waitcnt(0);
        unsigned nloc = b.st[0], nx = b.st[1];
        if (nloc == 0u) { xcd_barrier_complete(bar, b.x, nloc, nx); b.st[0] = nloc; b.st[1] = nx; }
        const unsigned old = xb_add(&bar[XB_XSUB(b.x)], 1u);
        const unsigned gen = old / nloc;
        if (old + 1u == (gen + 1u) * nloc) {
            __builtin_amdgcn_fence(__ATOMIC_RELEASE, "agent");
            asm volatile("s_waitcnt vmcnt(0)" ::: "memory");
            const unsigned og = xb_add(&bar[XB_TOP], 1u);
            const unsigned tg = og / nx;
            if (og + 1u == (tg + 1u) * nx) xb_add(&bar[XB_TOPGEN], 1u);
            else XB_SPIN(xb_ld(&bar[XB_TOPGEN]) == tg, bar);
            __builtin_amdgcn_fence(__ATOMIC_ACQUIRE, "agent");
            xb_add(&bar[XB_XGEN(b.x)], 1u);
            asm volatile("s_waitcnt vmcnt(0)" ::: "memory");
        } else {
            XB_SPIN(xb_ld(&bar[XB_XGEN(b.x)]) == gen, bar);
            __builtin_amdgcn_fence(__ATOMIC_ACQUIRE, "agent");
            asm volatile("s_waitcnt vmcnt(0)" ::: "memory");
        }
    }
    __syncthreads();
}

struct Args { const float* in[20]; float* out; unsigned char* ws; int ph_lo, ph_hi; };

struct Ctx {
    const float* const* in; unsigned char* ws; float* X; LAS unsigned char* lds;
    int tid, lane, wave, gtid, NT, gw, NGW, G;
};

__device__ __forceinline__ void conv_early(const Ctx& c, int l) {
    LAS float* scr = (LAS float*)(c.lds + c.wave * 16384);
    bf16_t* WINT = (bf16_t*)(c.ws + WS_WIN); bf16_t* WGT = (bf16_t*)(c.ws + WS_WG);
    const float* w_in = c.in[3] + (size_t)l * DM * WIN; const float* g_mix = c.in[2] + l * DM;
    const float* wr_ = c.in[6] + (size_t)l * 262144; const float* wi_ = c.in[8] + (size_t)l * 262144;
    constexpr int I_WIN = 16 * 224, I_G = 4 * 64;
    for (int it = c.gw; it < I_WIN + I_G; it += c.NGW) {
        if (it < I_WIN) { const int kb = it / 224, nb = it % 224, k0 = 64 * kb, n0 = 32 * nb;
            wconv_item(w_in + (size_t)k0 * WIN + win_src_col(n0), WIN, g_mix + k0, WINT + (size_t)n0 * DM + k0, DM, scr, c.lane); }
        else { const int r = it - I_WIN, kb = r / 64, nb = r % 64, k0 = 64 * kb, n0 = 32 * nb;
            const int h = n0 >> 9, jt = (n0 >> 8) & 1, half = (n0 >> 7) & 1, off = n0 & 127;
            const float* src = (half ? wi_ : wr_) + (size_t)h * 65536 + (size_t)k0 * 256 + 128 * jt + off;
            wconv_item(src, 256, nullptr, WGT + (size_t)n0 * 256 + k0, 256, scr, c.lane); }
    }
}
__device__ __forceinline__ void conv_late(const Ctx& c, int l) {
    LAS float* scr = (LAS float*)(c.lds + c.wave * 16384);
    bf16_t* WOUT = (bf16_t*)(c.ws + WS_WOUT); bf16_t* WGU = (bf16_t*)(c.ws + WS_WGU); bf16_t* WDN = (bf16_t*)(c.ws + WS_WDN); bf16_t* WPG = (bf16_t*)(c.ws + WS_WPG); bf16_t* WPLE = (bf16_t*)(c.ws + WS_WPLE);
    const float* w_out = c.in[12] + (size_t)l * DM * DM; const float* g_ffn = c.in[13] + l * DM; const float* w_gu = c.in[14] + (size_t)l * DM * 2 * DFF;
    const float* w_dn = c.in[15] + (size_t)l * DFF * DM; const float* g_ple = c.in[16] + l * DM; const float* w_pg = c.in[17] + (size_t)l * DM * DM; const float* w_ple = c.in[18] + (size_t)l * PLE * DM;
    constexpr int I_O = 16 * 32, I_GU = 16 * 176, I_DN = 44 * 32, I_PG = 16 * 32, I_PL = 4 * 32;
    for (int it = c.gw; it < I_O + I_GU + I_DN + I_PG + I_PL; it += c.NGW) {
        int r = it;
        if (r < I_O) { const int kb = r / 32, nb = r % 32, k0 = 64 * kb, n0 = 32 * nb; wconv_item(w_out + (size_t)k0 * DM + n0, DM, nullptr, WOUT + (size_t)n0 * DM + k0, DM, scr, c.lane); continue; } r -= I_O;
        if (r < I_GU) { const int kb = r / 176, nb = r % 176, k0 = 64 * kb, n0 = 32 * nb; const int pn = n0 >> 8, half = (n0 >> 7) & 1, off = n0 & 127;
            wconv_item(w_gu + (size_t)k0 * (2 * DFF) + half * DFF + 128 * pn + off, 2 * DFF, g_ffn + k0, WGU + (size_t)n0 * DM + k0, DM, scr, c.lane); continue; } r -= I_GU;
        if (r < I_DN) { const int kb = r / 32, nb = r % 32, k0 = 64 * kb, n0 = 32 * nb; wconv_item(w_dn + (size_t)k0 * DM + n0, DM, nullptr, WDN + (size_t)n0 * DFF + k0, DFF, scr, c.lane); continue; } r -= I_DN;
        if (r < I_PG) { const int kb = r / 32, nb = r % 32, k0 = 64 * kb, n0 = 32 * nb; wconv_item(w_pg + (size_t)k0 * DM + n0, DM, g_ple + k0, WPG + (size_t)n0 * DM + k0, DM, scr, c.lane); continue; } r -= I_PG;
        { const int kb = r / 32, nb = r % 32, k0 = 64 * kb, n0 = 32 * nb; wconv_item(w_ple + (size_t)k0 * DM + n0, DM, nullptr, WPLE + (size_t)n0 * PLE + k0, PLE, scr, c.lane); }
    }
    const float* p = c.in[1] + (size_t)l * M * PLE; bf16_t* PB = (bf16_t*)(c.ws + WS_PB);
    for (int it0 = c.gtid; it0 < M * PLE / 8; it0 += 4 * c.NT) {
        f32x4 a[4], b[4];
#pragma unroll
        for (int q = 0; q < 4; ++q) { const int it = it0 + q * c.NT; if (it < M * PLE / 8) { a[q] = *(const f32x4*)(p + (size_t)it * 8); b[q] = *(const f32x4*)(p + (size_t)it * 8 + 4); } }
#pragma unroll
        for (int q = 0; q < 4; ++q) { const int it = it0 + q * c.NT; if (it < M * PLE / 8) {
            u32x4 w; w.x = cvt_pk_bf16(a[q].x, a[q].y); w.y = cvt_pk_bf16(a[q].z, a[q].w); w.z = cvt_pk_bf16(b[q].x, b[q].y); w.w = cvt_pk_bf16(b[q].z, b[q].w); *(u32x4*)(PB + (size_t)it * 8) = w; } }
    }
}

__device__ __forceinline__ float wave_sum(float v) {
#pragma unroll
    for (int o = 1; o < 64; o <<= 1) v += __shfl_xor(v, o);
    return v;
}

__device__ __forceinline__ void prologue(const Ctx& c) {
    const float* x = c.in[0]; bf16_t* XB = (bf16_t*)c.X; float* ssq1 = (float*)(c.ws + WS_SSQ1);
    for (int m0 = c.gw * 4; m0 < M; m0 += c.NGW * 4) {
        f32x4 v[4][4];
#pragma unroll
        for (int r = 0; r < 4; ++r) { const f32x4* xr = (const f32x4*)(x + (size_t)(m0 + r) * DM) + c.lane;
#pragma unroll
            for (int j = 0; j < 4; ++j) v[r][j] = xr[64 * j]; }
#pragma unroll
        for (int r = 0; r < 4; ++r) { const int m = m0 + r; float s = 0.f;
#pragma unroll
            for (int j = 0; j < 4; ++j) s += (v[r][j].x * v[r][j].x + v[r][j].y * v[r][j].y) + (v[r][j].z * v[r][j].z + v[r][j].w * v[r][j].w);
            s = wave_sum(s);
            u32x2* o = (u32x2*)(XB + (size_t)m * DM) + c.lane;
#pragma unroll
            for (int j = 0; j < 4; ++j) { u32x2 w; w.x = cvt_pk_bf16(v[r][j].x, v[r][j].y); w.y = cvt_pk_bf16(v[r][j].z, v[r][j].w); o[64 * j] = w; }
            if (c.lane < 16) ssq1[(size_t)m * 16 + c.lane] = (c.lane == 0) ? s : 0.f; }
    }
    float* sp8 = (float*)(c.ws + WS_SP8); const float* lam = c.in[10];
    for (int i = c.gtid; i < DEPTH * DM; i += c.NT) sp8[i] = 8.0f * log1pf(expf(-lam[i]));
    conv_early(c, 0);
}

__device__ __forceinline__ void conv4_phase(const Ctx& c, int l) {
    const bf16_t* RX = (const bf16_t*)(c.ws + WS_RX); bf16_t* XC = (bf16_t*)(c.ws + WS_XC);
    const float* w4 = c.in[4] + (size_t)l * 4 * DM; const float* b4 = c.in[5] + l * DM;
    for (int item = c.gtid; item < (M / 8) * 128; item += c.NT) {
        const int run = item >> 7, c0 = (item & 127) * 8, t0 = run * 8;
        float w[4][8], b[8];
#pragma unroll
        for (int k = 0; k < 4; ++k) { const f32x4 a = *(const f32x4*)(w4 + k * DM + c0), bb = *(const f32x4*)(w4 + k * DM + c0 + 4);
            w[k][0] = a.x; w[k][1] = a.y; w[k][2] = a.z; w[k][3] = a.w; w[k][4] = bb.x; w[k][5] = bb.y; w[k][6] = bb.z; w[k][7] = bb.w; }
        { const f32x4 a = *(const f32x4*)(b4 + c0), bb = *(const f32x4*)(b4 + c0 + 4); b[0] = a.x; b[1] = a.y; b[2] = a.z; b[3] = a.w; b[4] = bb.x; b[5] = bb.y; b[6] = bb.z; b[7] = bb.w; }
        float h0[8], h1[8], h2[8];
        if ((t0 & (SEQ - 1)) == 0) {
#pragma unroll
            for (int e = 0; e < 8; ++e) { h0[e] = 0.f; h1[e] = 0.f; h2[e] = 0.f; }
        } else {
            unpack8(*(const u32x4*)(RX + (size_t)(t0 - 3) * DM + c0), h0); unpack8(*(const u32x4*)(RX + (size_t)(t0 - 2) * DM + c0), h1); unpack8(*(const u32x4*)(RX + (size_t)(t0 - 1) * DM + c0), h2);
        }
        u32x4 wrow[8];
#pragma unroll
        for (int i = 0; i < 8; ++i) wrow[i] = *(const u32x4*)(RX + (size_t)(t0 + i) * DM + c0);
#pragma unroll
        for (int i = 0; i < 8; ++i) { float f[8], o[8]; unpack8(wrow[i], f);
#pragma unroll
            for (int e = 0; e < 8; ++e) { o[e] = b[e] + w[0][e] * h0[e] + w[1][e] * h1[e] + w[2][e] * h2[e] + w[3][e] * f[e]; h0[e] = h1[e]; h1[e] = h2[e]; h2[e] = f[e]; }
            *(u32x4*)(XC + (size_t)(t0 + i) * DM + c0) = pack8(o); }
    }
}

__device__ __forceinline__ void scan_local(const Ctx& c, int l) {
    bf16_t* PR = (bf16_t*)(c.ws + WS_RX); bf16_t* PI = (bf16_t*)(c.ws + WS_U); const bf16_t* XC = (const bf16_t*)(c.ws + WS_XC);
    float* PS = (float*)(c.ws + WS_PS); float* HS = (float*)(c.ws + WS_HS); const float* sp8 = (const float*)(c.ws + WS_SP8) + l * DM;
    for (int item = c.gtid; item < NCHUNK * 256; item += c.NT) {
        const int chunk = item >> 8, c0 = (item & 255) * 4;
        const f32x4 sp = *(const f32x4*)(sp8 + c0);
        f32x4 hl = (f32x4){0.f, 0.f, 0.f, 0.f}, cp = (f32x4){1.f, 1.f, 1.f, 1.f};
        const size_t base = (size_t)chunk * LCH * DM + c0;
        u32x2 nr_[8], ni_[8], nx_[8];
#pragma unroll
        for (int j = 0; j < 8; ++j) { const size_t o = base + (size_t)j * DM; nr_[j] = *(const u32x2*)(PR + o); ni_[j] = *(const u32x2*)(PI + o); nx_[j] = *(const u32x2*)(XC + o); }
#pragma unroll 1
        for (int tb = 0; tb < LCH; tb += 8) {
            u32x2 wr_[8], wi_[8], wx_[8];
#pragma unroll
            for (int j = 0; j < 8; ++j) { wr_[j] = nr_[j]; wi_[j] = ni_[j]; wx_[j] = nx_[j]; }
            if (tb + 8 < LCH) {
#pragma unroll
                for (int j = 0; j < 8; ++j) { const size_t o = base + (size_t)(tb + 8 + j) * DM; nr_[j] = *(const u32x2*)(PR + o); ni_[j] = *(const u32x2*)(PI + o); nx_[j] = *(const u32x2*)(XC + o); } }
#pragma unroll
            for (int j = 0; j < 8; ++j) {
                const f32x4 pr = unpack4v(wr_[j]), pi = unpack4v(wi_[j]), xc = unpack4v(wx_[j]);
                const f32x4 r = sigm4(pr), ig = sigm4(pi);
                const f32x4 lg = -(r * sp), x2 = lg + lg;
                f32x4 em = x2 * (x2 * (x2 * (x2 * (x2 * (x2 * 0.0013888889f + 0.0083333338f) + 0.041666668f) + 0.16666667f) + 0.5f) + 1.0f);
                if (__builtin_amdgcn_ballot_w64((x2.x <= -0.25f) | (x2.y <= -0.25f) | (x2.z <= -0.25f) | (x2.w <= -0.25f)) != 0ull) {
#pragma unroll
                    for (int e = 0; e < 4; ++e) if (x2[e] <= -0.25f) em[e] = __expf(x2[e]) - 1.f; }
                f32x4 s; s.x = __builtin_amdgcn_sqrtf(-em.x); s.y = __builtin_amdgcn_sqrtf(-em.y); s.z = __builtin_amdgcn_sqrtf(-em.z); s.w = __builtin_amdgcn_sqrtf(-em.w);
                const f32x4 a = exp2n4(-lg), uu = s * ig * xc;
                hl = a * hl + uu; cp = cp * a;
                const size_t o = base + (size_t)(tb + j) * DM;
                *(u32x2*)(PI + o) = pack4(hl); *(u32x2*)(PR + o) = pack4(cp); }
        }
        *(f32x4*)(PS + (size_t)chunk * DM + c0) = cp; *(f32x4*)(HS + (size_t)chunk * DM + c0) = hl;
    }
}
__device__ __forceinline__ void merge_phase(const Ctx& c, int l, unsigned bx) {
    const bf16_t* CP = (const bf16_t*)(c.ws + WS_RX); const bf16_t* HL = (const bf16_t*)(c.ws + WS_U); const bf16_t* CX = (const bf16_t*)(c.ws + WS_CX);
    const bf16_t* GY = (const bf16_t*)(c.ws + WS_GY); const bf16_t* GB = (const bf16_t*)(c.ws + WS_GB); bf16_t* MG = (bf16_t*)(c.ws + WS_XC);
    const float* PS = (const float*)(c.ws + WS_PS); const float* HS = (const float*)(c.ws + WS_HS); const float* w3 = c.in[11] + (size_t)l * 3 * DM;
    LAS float* carr = (LAS float*)c.lds;
    constexpr int CPS = SEQ / LCH;
    for (int rb = (int)bx; rb < M / 128; rb += c.G) {
        const int k0 = 2 * rb, kk0 = k0 % CPS, kbase = k0 - kk0;
        { const int c2 = 2 * c.tid; f32x2 carry = (f32x2){0.f, 0.f};
#pragma unroll 1
          for (int k = 0; k < kk0; k += 16) {
              f32x2 P[16], H[16];
#pragma unroll
              for (int j = 0; j < 16; ++j) { const int kc = (k + j < kk0) ? (k + j) : (kk0 - 1); P[j] = *(const f32x2*)(PS + (size_t)(kbase + kc) * DM + c2); H[j] = *(const f32x2*)(HS + (size_t)(kbase + kc) * DM + c2); }
#pragma unroll
              for (int j = 0; j < 16; ++j) { if (k + j < kk0) carry = P[j] * carry + H[j]; } }
          const f32x2 P = *(const f32x2*)(PS + (size_t)k0 * DM + c2), H = *(const f32x2*)(HS + (size_t)k0 * DM + c2);
          const f32x2 carry1 = P * carry + H;
          carr[c2] = carry.x; carr[c2 + 1] = carry.y; carr[DM + c2] = carry1.x; carr[DM + c2 + 1] = carry1.y; }
        __syncthreads();
#pragma unroll 1
        for (int it = 0; it < 4; ++it) {
            const int item = c.tid + 512 * it, run = item >> 7, c0 = (item & 127) * 8, t0 = rb * 128 + run * 8;
            float w[3][8], cr[8];
#pragma unroll
            for (int k = 0; k < 3; ++k) { const f32x4 a = *(const f32x4*)(w3 + k * DM + c0), bb = *(const f32x4*)(w3 + k * DM + c0 + 4);
                w[k][0] = a.x; w[k][1] = a.y; w[k][2] = a.z; w[k][3] = a.w; w[k][4] = bb.x; w[k][5] = bb.y; w[k][6] = bb.z; w[k][7] = bb.w; }
            { const LAS f32x4* cp4 = (const LAS f32x4*)(carr + (run >> 3) * DM + c0); const f32x4 a = cp4[0], bb = cp4[1]; cr[0] = a.x; cr[1] = a.y; cr[2] = a.z; cr[3] = a.w; cr[4] = bb.x; cr[5] = bb.y; cr[6] = bb.z; cr[7] = bb.w; }
            float p0[8], p1[8];
            if ((t0 & (SEQ - 1)) == 0) {
#pragma unroll
                for (int e = 0; e < 8; ++e) { p0[e] = 0.f; p1[e] = 0.f; }
            } else { unpack8(*(const u32x4*)(CX + (size_t)(t0 - 2) * DM + c0), p0); unpack8(*(const u32x4*)(CX + (size_t)(t0 - 1) * DM + c0), p1); }
#pragma unroll
            for (int ib = 0; ib < 8; ib += 4) {
                u32x4 whl[4], wcp[4], wgy[4], wgb[4], wcx[4];
#pragma unroll
                for (int i = 0; i < 4; ++i) { const size_t off = (size_t)(t0 + ib + i) * DM + c0;
                    whl[i] = *(const u32x4*)(HL + off); wcp[i] = *(const u32x4*)(CP + off); wgy[i] = *(const u32x4*)(GY + off); wgb[i] = *(const u32x4*)(GB + off); wcx[i] = *(const u32x4*)(CX + off); }
#pragma unroll
                for (int i = 0; i < 4; ++i) { const size_t off = (size_t)(t0 + ib + i) * DM + c0;
                    float hl[8], cp[8], gy[8], gb[8], cx[8], o[8];
                    unpack8(whl[i], hl); unpack8(wcp[i], cp); unpack8(wgy[i], gy); unpack8(wgb[i], gb); unpack8(wcx[i], cx);
#pragma unroll
                    for (int e = 0; e < 8; ++e) { const float h = hl[e] + cp[e] * cr[e]; o[e] = gy[e] * h + gb[e] * (w[0][e] * p0[e] + w[1][e] * p1[e] + w[2][e] * cx[e]); p0[e] = p1[e]; p1[e] = cx[e]; }
                    *(u32x4*)(MG + off) = pack8(o); }
            }
        }
        __syncthreads();
    }
}
__device__ __forceinline__ void final_phase(const Ctx& c) {
    const float* ssq = (const float*)(c.ws + WS_SSQ1); const float* g = c.in[19]; const bf16_t* xl = (const bf16_t*)(c.ws + WS_XC);
    f32x4 gv[4];
#pragma unroll
    for (int j = 0; j < 4; ++j) gv[j] = ((const f32x4*)g)[c.lane + 64 * j];
    for (int m0 = c.gw * 4; m0 < M; m0 += c.NGW * 4) {
        u32x2 xw[4][4]; float rs[4];
#pragma unroll
        for (int r = 0; r < 4; ++r) { const u32x2* xr = (const u32x2*)(xl + (size_t)(m0 + r) * DM) + c.lane; rs[r] = row_rstd(ssq, m0 + r);
#pragma unroll
            for (int j = 0; j < 4; ++j) xw[r][j] = xr[64 * j]; }
#pragma unroll
        for (int r = 0; r < 4; ++r) { f32x4* orow = (f32x4*)((float*)c.X + (size_t)(m0 + r) * DM) + c.lane;
#pragma unroll
            for (int j = 0; j < 4; ++j) orow[64 * j] = unpack4v(xw[r][j]) * rs[r] * gv[j]; }
    }
}

__global__ void __launch_bounds__(512, 2) fwd_mega(Args a) {
    extern __shared__ __attribute__((aligned(16))) unsigned char lds_raw[];
    cg::grid_group grid = cg::this_grid();
    volatile LAS unsigned* bst = (volatile LAS unsigned*)((LAS unsigned char*)lds_raw + RING_BYTES + 256);
    if (threadIdx.x < 8) bst[threadIdx.x] = 0u;
    __syncthreads();
    const XcdBarrier xbar = xcd_barrier_post((unsigned*)(a.ws + WS_BAR), bst);
    unsigned* xcnt = (unsigned*)(a.ws + WS_BAR) + 3584;
    if (threadIdx.x == 0) bst[4] = xb_add(&xcnt[64 * xbar.x], 1u);
    __syncthreads();
    const unsigned my_rank = (unsigned)__builtin_amdgcn_readfirstlane((int)bst[4]);
    unsigned vcu = blockIdx.x; bool vcu_known = false;
#ifndef KREP_WIN
#define KREP_WIN 1
#endif
#ifndef DUPMASK
#define DUPMASK 0
#endif
#ifndef EXTRA_SYNCS
#define EXTRA_SYNCS 0
#endif
    bool dup_done = false;
    for (int ph = a.ph_lo; ph < a.ph_hi; ++ph) {
        if (!vcu_known && ph > a.ph_lo) {
            bool ok = (gridDim.x % 8u) == 0u;
            for (unsigned j = 0; j < 8; ++j) ok = ok && ((unsigned)__builtin_amdgcn_readfirstlane((int)xb_ld(&xcnt[64 * j])) == gridDim.x / 8u);
            if (ok && xbar.x < 8u && my_rank < gridDim.x / 8u) vcu = my_rank * 8u + xbar.x;
            vcu_known = true;
        }
        int tid_ = threadIdx.x; unsigned bx_ = vcu; size_t zoff_ = 0;
        asm volatile("" : "+v"(tid_)); asm volatile("" : "+s"(bx_)); asm volatile("" : "+s"(zoff_));
        unsigned char* ws = a.ws + zoff_; float* outp = a.out + zoff_;
        Ctx c;
        c.in = a.in; c.ws = ws; c.X = outp; c.lds = (LAS unsigned char*)lds_raw;
        c.tid = tid_; c.lane = c.tid & 63; c.wave = __builtin_amdgcn_readfirstlane(c.tid >> 6);
        c.G = gridDim.x; c.gtid = bx_ * 512 + c.tid; c.NT = c.G * 512; c.gw = bx_ * 8 + c.wave; c.NGW = c.G * 8;
        bf16_t* XB = (bf16_t*)(ws + WS_XB);
        bf16_t* XBA = (bf16_t*)outp;
        float* ssq1 = (float*)(ws + WS_SSQ1); float* ssq2 = (float*)(ws + WS_SSQ2); float* ssq3 = (float*)(ws + WS_SSQ3);
        if (ph == 0) prologue(c);
        else if (ph == 1 + NSUB * DEPTH) final_phase(c);
        else {
            const int l = (ph - 1) / NSUB, s = (ph - 1) % NSUB;
            pg8::StaticOrder S;
            switch (s) {
#if !defined(ONLY) || ONLY == 0
            case 0: {
                pg8::Gemm g{XBA, (const bf16_t*)(ws + WS_WIN)}; S.init(M, WIN, c.G, bx_);
                pg8::EpiWin E{(bf16_t*)(ws + WS_RX), (bf16_t*)(ws + WS_CX), ssq1, (const LAS float*)(c.lds + SSQ_TAB_OFF)};
                pg8::gemm_phase<DM, DM, DM, 0, KREP_WIN>(c.lds, c.tid, g, S, E); } break;
#endif
#if !defined(ONLY) || ONLY == 1
            case 1: conv4_phase(c, l); conv_late(c, l); break;
#endif
#if !defined(ONLY) || ONLY == 2
            case 2: {
                pg8::Gemm g{(const bf16_t*)(ws + WS_XC), (const bf16_t*)(ws + WS_WG)}; S.init(M, 2048, c.G, bx_);
                pg8::EpiGateScan E{(const bf16_t*)(ws + WS_XC), (bf16_t*)(ws + WS_RX), (bf16_t*)(ws + WS_U), (float*)(ws + WS_PS), (float*)(ws + WS_HS), a.in[7] + l * DM, a.in[9] + l * DM, (const float*)(ws + WS_SP8) + l * DM};
                pg8::gemm_phase<256, DM, 256, 256>(c.lds, c.tid, g, S, E); } break;
#endif
#if !defined(ONLY) || ONLY == 5
            case 3: merge_phase(c, l, bx_); if (l + 1 < DEPTH) conv_early(c, l + 1); break;
#endif
#if !defined(ONLY) || ONLY == 6
            case 4: {
                { pg8::Gemm g{(const bf16_t*)(ws + WS_XC), (const bf16_t*)(ws + WS_WOUT)}; S.init(M, DM, c.G, bx_);
                  pg8::EpiRes E{XBA, XB, ssq2};
                  pg8::gemm_phase<DM, DM, DM, 0>(c.lds, c.tid, g, S, E); }
                { int tid2 = c.tid; asm volatile("" : "+v"(tid2));
                  pg8::Gemm g{(const bf16_t*)(ws + WS_PB), (const bf16_t*)(ws + WS_WPLE)}; S.init(M, DM, c.G, bx_);
                  pg8::EpiBf E{(bf16_t*)(ws + WS_U), DM};
                  pg8::gemm_phase<PLE, PLE, PLE, 0>(c.lds, tid2, g, S, E); } } break;
#endif
#if !defined(ONLY) || ONLY == 7
            case 5: {
                pg8::Gemm g{XB, (const bf16_t*)(ws + WS_WGU)}; S.init(M, 2 * DFF, c.G, bx_);
                pg8::EpiSwi E{(bf16_t*)(ws + WS_ACT), ssq2, (const LAS float*)(c.lds + SSQ_TAB_OFF)};
                pg8::gemm_phase<DM, DM, DM, 0>(c.lds, c.tid, g, S, E); } break;
#endif
#if !defined(ONLY) || ONLY == 8
            case 6: {
                pg8::Gemm g{(const bf16_t*)(ws + WS_ACT), (const bf16_t*)(ws + WS_WDN)}; S.init(M, DM, c.G, bx_);
                pg8::EpiRes E{XB, XB, ssq3};
                pg8::gemm_phase<DFF, DFF, DFF, 0>(c.lds, c.tid, g, S, E); } break;
#endif
#if !defined(ONLY) || ONLY == 9
            default: {
                pg8::Gemm g{XB, (const bf16_t*)(ws + WS_WPG)}; S.init(M, DM, c.G, bx_);
                pg8::EpiPle E{XB, (l == DEPTH - 1) ? (bf16_t*)(ws + WS_XC) : XBA, (const bf16_t*)(ws + WS_U), ssq3, ssq1, (const LAS float*)(c.lds + SSQ_TAB_OFF)};
                pg8::gemm_phase<DM, DM, DM, 0>(c.lds, c.tid, g, S, E); } break;
#endif
            }
        }
        if (ph + 1 < a.ph_hi) { if (a.ph_hi < 0) grid.sync(); else xcd_barrier(xbar); }
        for (int xs = 0; xs < EXTRA_SYNCS; ++xs) xcd_barrier(xbar);
        if (DUPMASK != 0 && ph >= 1 && ph <= NSUB * DEPTH && ((DUPMASK >> ((ph - 1) % NSUB)) & 1) && !dup_done) { dup_done = true; --ph; } else dup_done = false;
    }
}

extern "C" void kernel_launch(void* const* d_in, const int* in_sizes, int n_in, void* d_out, int out_size, void* d_ws, size_t ws_size, hipStream_t stream) {
    static int grid = 0;
    if (grid == 0) {
        if (n_in != 20 || out_size != M * DM || ws_size < WS_END) { fprintf(stderr, "kernel_launch: unexpected sizes n_in %d out %d ws %zu\n", n_in, out_size, ws_size); grid = -1; return; }
        int dev = 0, cus = 0, per_cu = 0;
        hipGetDevice(&dev); hipDeviceGetAttribute(&cus, hipDeviceAttributeMultiprocessorCount, dev);
        if (hipFuncSetAttribute((const void*)fwd_mega, hipFuncAttributeMaxDynamicSharedMemorySize, LDS_BYTES) != hipSuccess) { fprintf(stderr, "kernel_launch: hipFuncSetAttribute failed\n"); grid = -1; return; }
        if (hipOccupancyMaxActiveBlocksPerMultiprocessor(&per_cu, (const void*)fwd_mega, 512, LDS_BYTES) != hipSuccess || per_cu < 1) { fprintf(stderr, "kernel_launch: occupancy query gives %d\n", per_cu); per_cu = 1; }
        (void)hipGetLastError();
        grid = cus * 1;
    }
    if (grid < 0) return;
    if (hipMemsetAsync((char*)d_ws + WS_BAR, 0, BAR_BYTES, stream) != hipSuccess) { fprintf(stderr, "kernel_launch: memset failed\n"); return; }
    Args a{};
    for (int i = 0; i < 20; ++i) a.in[i] = (const float*)d_in[i];
    a.out = (float*)d_out; a.ws = (unsigned char*)d_ws; a.ph_lo = 0; a.ph_hi = 2 + NSUB * DEPTH;
    void* args[] = {&a};
    hipError_t e = hipLaunchCooperativeKernel((const void*)fwd_mega, dim3(grid), dim3(512), args, LDS_BYTES, stream);
    if (e != hipSuccess) fprintf(stderr, "cooperative launch failed: %s (grid %d)\n", hipGetErrorString(e), grid);
}
```

```cpp
#include <hip/hip_runtime.h>
#include <hip/hip_cooperative_groups.h>
#include <cstdio>
#include <cstdint>
namespace cg = cooperative_groups;

#define LAS __attribute__((address_space(3)))
typedef unsigned short bf16_t;
typedef short bf16x8 __attribute__((ext_vector_type(8)));
typedef float f32x4 __attribute__((ext_vector_type(4)));
typedef float f32x2 __attribute__((ext_vector_type(2)));
typedef unsigned u32x4 __attribute__((ext_vector_type(4)));
typedef unsigned u32x2 __attribute__((ext_vector_type(2)));

constexpr int DM = 1024, BATCH = 4, SEQ = 8192, DEPTH = 4, M = BATCH * SEQ;
constexpr int DFF = 2816, WIN = 7168, PLE = 256;
constexpr int LCH = 64, NCHUNK = M / LCH;
constexpr float EPS = 1e-6f;

constexpr size_t MiB = 1u << 20;
constexpr size_t WS_SSQ1 = 0 * MiB, WS_SSQ2 = 2 * MiB, WS_SSQ3 = 4 * MiB, WS_PS = 6 * MiB, WS_HS = 8 * MiB, WS_CARRY = 10 * MiB, WS_SP8 = 12 * MiB;
constexpr size_t WS_BAR = 13 * MiB, BAR_BYTES = 16384;
constexpr size_t WS_WIN = 16 * MiB;
constexpr size_t WS_WG = 30 * MiB;
constexpr size_t WS_WOUT = 32 * MiB;
constexpr size_t WS_WGU = 34 * MiB;
constexpr size_t WS_WDN = 45 * MiB;
constexpr size_t WS_WPG = 51 * MiB;
constexpr size_t WS_WPLE = 53 * MiB;
constexpr size_t WS_PB = 56 * MiB;
constexpr size_t WS_XB = 72 * MiB;
constexpr size_t WS_RX = 136 * MiB;
constexpr size_t WS_CX = 200 * MiB;
constexpr size_t WS_GY = 264 * MiB;
constexpr size_t WS_GB = 328 * MiB;
constexpr size_t WS_XC = 392 * MiB;
constexpr size_t WS_U = 456 * MiB;
constexpr size_t WS_ACT = 136 * MiB;
constexpr size_t WS_END = 520 * MiB;
static_assert(WS_GY == WS_CX + 64 * MiB && WS_GB == WS_GY + 64 * MiB, "CX | GY | GB consecutive");

constexpr int NSUB = 8;
constexpr int RING_BYTES = 131072;
constexpr int SSQ_TAB_OFF = RING_BYTES + 1024;
constexpr int LDS_BYTES = SSQ_TAB_OFF + 16384 + 1024;

__device__ __forceinline__ unsigned cvt_pk_bf16(float lo, float hi) { unsigned r; asm("v_cvt_pk_bf16_f32 %0, %1, %2" : "=v"(r) : "v"(lo), "v"(hi)); return r; }
__device__ __forceinline__ u32x4 pack8(const float (&f)[8]) { u32x4 w; w.x = cvt_pk_bf16(f[0], f[1]); w.y = cvt_pk_bf16(f[2], f[3]); w.z = cvt_pk_bf16(f[4], f[5]); w.w = cvt_pk_bf16(f[6], f[7]); return w; }
__device__ __forceinline__ void unpack8(const u32x4 w, float (&f)[8]) {
    f[0] = __uint_as_float(w.x << 16); f[1] = __uint_as_float(w.x & 0xffff0000u); f[2] = __uint_as_float(w.y << 16); f[3] = __uint_as_float(w.y & 0xffff0000u);
    f[4] = __uint_as_float(w.z << 16); f[5] = __uint_as_float(w.z & 0xffff0000u); f[6] = __uint_as_float(w.w << 16); f[7] = __uint_as_float(w.w & 0xffff0000u); }
__device__ __forceinline__ void unpack4(const u32x2 w, float (&f)[4]) {
    f[0] = __uint_as_float(w.x << 16); f[1] = __uint_as_float(w.x & 0xffff0000u); f[2] = __uint_as_float(w.y << 16); f[3] = __uint_as_float(w.y & 0xffff0000u); }
__device__ __forceinline__ float sigm(float v) { return __builtin_amdgcn_rcpf(1.f + __expf(-v)); }
__device__ __forceinline__ float gelu_tanh(float v) { return v * sigm(1.5957691216057308f * (v + 0.044715f * v * v * v)); }
__device__ __forceinline__ float row_rstd(const float* ssq, int row) {
    const f32x4* p = (const f32x4*)(ssq + (size_t)row * 16);
    const f32x4 a = p[0], b = p[1], c = p[2], d = p[3];
    const float s = (((a.x + a.y) + (a.z + a.w)) + ((b.x + b.y) + (b.z + b.w))) + (((c.x + c.y) + (c.z + c.w)) + ((d.x + d.y) + (d.z + d.w)));
    return rsqrtf(s * (1.0f / DM) + EPS);
}
__device__ __forceinline__ float row_rstd_q(const float* ssq, int row, int fq) {
    const f32x4 a = *(const f32x4*)(ssq + (size_t)row * 16 + fq * 4);
    float s = (a.x + a.y) + (a.z + a.w); s += __shfl_xor(s, 16); s += __shfl_xor(s, 32);
    return rsqrtf(s * (1.0f / DM) + EPS);
}
__device__ __forceinline__ f32x4 exp2n4(f32x4 x) {
    const f32x4 a = x * (-1.4426950408889634f); f32x4 e; e.x = __builtin_amdgcn_exp2f(a.x); e.y = __builtin_amdgcn_exp2f(a.y); e.z = __builtin_amdgcn_exp2f(a.z); e.w = __builtin_amdgcn_exp2f(a.w); return e; }
__device__ __forceinline__ f32x4 rcp4(f32x4 d) { f32x4 r; r.x = __builtin_amdgcn_rcpf(d.x); r.y = __builtin_amdgcn_rcpf(d.y); r.z = __builtin_amdgcn_rcpf(d.z); r.w = __builtin_amdgcn_rcpf(d.w); return r; }
__device__ __forceinline__ f32x4 sigm4(f32x4 x) { return rcp4(exp2n4(x) + 1.0f); }
__device__ __forceinline__ u32x2 pack4(f32x4 v) { u32x2 w; w.x = cvt_pk_bf16(v.x, v.y); w.y = cvt_pk_bf16(v.z, v.w); return w; }
__device__ __forceinline__ f32x4 unpack4v(const u32x2 w) { return (f32x4){__uint_as_float(w.x << 16), __uint_as_float(w.x & 0xffff0000u), __uint_as_float(w.y << 16), __uint_as_float(w.y & 0xffff0000u)}; }
__device__ __forceinline__ float row_rstd_lds(const LAS float* tab, int rl, int fq) {
    const f32x4 a = *(const LAS f32x4*)(tab + rl * 16 + fq * 4);
    float s = (a.x + a.y) + (a.z + a.w); s += __shfl_xor(s, 16); s += __shfl_xor(s, 32);
    return rsqrtf(s * (1.0f / DM) + EPS);
}
#define EPI_FENCE() asm volatile("" ::: "memory")
#define LDS_WAIT() asm volatile("s_waitcnt lgkmcnt(0)" ::: "memory")

namespace pg8 {
constexpr int BM = 256, BK = 64, HALF = 128, HTB = HALF * BK * 2, NXCD = 8, WGM = 8;
__host__ __device__ __forceinline__ int lds_byte(int r, int c) { const int st = (r >> 4) * 2 + (c >> 5), rr = r & 15, cc = c & 31, ob = rr * 64 + cc * 2; return st * 1024 + (ob ^ (((ob >> 9) & 1) << 5)); }
__host__ __device__ __forceinline__ void stage_rc(int b, int& R, int& C) { const int st = b / 1024, sb = b % 1024, swz = sb ^ (((sb >> 9) & 1) << 5); R = (st >> 1) * 16 + swz / 64; C = (st & 1) * 32 + (swz % 64) / 2; }
__host__ __device__ __forceinline__ int perm32(int rho) { const int n = rho >> 4, i = rho & 15; return 8 * (i >> 2) + 4 * n + (i & 3); }

struct Unit { int pm, pn; };
struct Gemm { const bf16_t* A; const bf16_t* Bt; };

struct StaticOrder {
    int nM, nN, nwg, G, c;
    __device__ void init(int M_, int N_, int G_, int c_) { nM = M_ / BM; nN = N_ / BM; nwg = nM * nN; G = G_; c = c_; }
    __device__ bool next(int i, Unit& u) const {
        const long L = (long)i * G + c; if (L >= nwg) return false;
        int wgid = (int)L; { const int q = nwg / NXCD, r = nwg % NXCD, xcd = wgid % NXCD, off = wgid / NXCD; wgid = (xcd < r ? xcd * (q + 1) : r * (q + 1) + (xcd - r) * q) + off; }
        const int nig = WGM * nN, gid = wgid / nig, fm = gid * WGM, gsz = (nM - fm) < WGM ? (nM - fm) : WGM;
        u.pm = fm + ((wgid % nig) % gsz); u.pn = (wgid % nig) / gsz; return true;
    }
};

typedef f32x4 Acc[2][2][4][2];

struct EpiWin {
    static constexpr bool PREF = true;
    bf16_t* RX; bf16_t* CX; const float* ssq; const LAS float* tab;
    __device__ __forceinline__ void operator()(const Acc& acc, const Unit& u, int wr, int wc, int fr, int fq) const {
        const int row0 = u.pm * BM + wr * 64 + fr;
        float rsv[2][4];
#pragma unroll
        for (int ai = 0; ai < 2; ++ai)
#pragma unroll
            for (int m = 0; m < 4; ++m) rsv[ai][m] = row_rstd_lds(tab, wr * 64 + fr + ai * HALF + m * 16, fq);
        EPI_FENCE();
        if (u.pn < 4) {
#pragma unroll
            for (int ai = 0; ai < 2; ++ai)
#pragma unroll
                for (int m = 0; m < 4; ++m) { const int row = row0 + ai * HALF + m * 16; const float rs = rsv[ai][m];
                    bf16_t* rp = RX + (size_t)row * DM + u.pn * BM + wc * 32 + 8 * fq;
#pragma unroll
                    for (int bj = 0; bj < 2; ++bj) { const u32x2 p0 = pack4(acc[ai][bj][m][0] * rs), p1 = pack4(acc[ai][bj][m][1] * rs);
                        *(u32x4*)(rp + bj * HALF) = (u32x4){p0.x, p0.y, p1.x, p1.y}; } EPI_FENCE(); }
        } else {
            const int q = (u.pn - 4) >> 3, j = (u.pn - 4) & 7;
            bf16_t* dst = CX + (size_t)q * (size_t)(32u << 20) + j * 128 + wc * 32 + 8 * fq;
#pragma unroll
            for (int ai = 0; ai < 2; ++ai)
#pragma unroll
                for (int m = 0; m < 4; ++m) { const int row = row0 + ai * HALF + m * 16; const float rs = rsv[ai][m];
                    u32x4 w;
#pragma unroll
                    for (int n = 0; n < 2; ++n) { const f32x4 v0 = acc[ai][0][m][n] * rs, v1 = acc[ai][1][m][n] * rs; f32x4 o;
                        if (q == 0) o = v0 * v1;
                        else if (q == 1) { const f32x4 t = (v0 * v0 * 0.044715f + 1.0f) * v0 * 1.5957691216057308f;
                            o = v0 * rcp4((exp2n4(t) + 1.0f) * (exp2n4(v1) + 1.0f)); }
                        else o = v0 * sigm4(v1);
                        const u32x2 p = pack4(o); if (n == 0) { w.x = p.x; w.y = p.y; } else { w.z = p.x; w.w = p.y; } }
                    *(u32x4*)(dst + (size_t)row * DM) = w; EPI_FENCE(); }
        }
    }
};
struct EpiGate {
    static constexpr bool PREF = false;
    bf16_t* PR; bf16_t* PI; const float* br; const float* bi;
    __device__ __forceinline__ void operator()(const Acc& acc, const Unit& u, int wr, int wc, int fr, int fq) const {
        const int row0 = u.pm * BM + wr * 64 + fr;
        const int c0 = (u.pn >> 1) * 256 + (u.pn & 1) * 128 + wc * 32 + 8 * fq;
        const f32x4 br0 = *(const f32x4*)(br + c0), br1 = *(const f32x4*)(br + c0 + 4), bi0 = *(const f32x4*)(bi + c0), bi1 = *(const f32x4*)(bi + c0 + 4);
#pragma unroll
        for (int ai = 0; ai < 2; ++ai)
#pragma unroll
            for (int m = 0; m < 4; ++m) { const int row = row0 + ai * HALF + m * 16; const unsigned off = (unsigned)row * DM + c0;
                const u32x2 r0 = pack4(acc[ai][0][m][0] + br0), r1 = pack4(acc[ai][0][m][1] + br1), i0 = pack4(acc[ai][1][m][0] + bi0), i1 = pack4(acc[ai][1][m][1] + bi1);
                *(u32x4*)(PR + off) = (u32x4){r0.x, r0.y, r1.x, r1.y}; *(u32x4*)(PI + off) = (u32x4){i0.x, i0.y, i1.x, i1.y}; EPI_FENCE(); }
    }
};
template <int N> __device__ __forceinline__ float dpp_row_shr(float v, float ident) {
    return __int_as_float(__builtin_amdgcn_update_dpp(__float_as_int(ident), __float_as_int(v), 0x110 | N, 0xf, 0xf, false)); }
template <int N> __device__ __forceinline__ void scan_step(f32x4& a, f32x4& uu) {
#pragma unroll
    for (int e = 0; e < 4; ++e) { const float ap = dpp_row_shr<N>(a[e], 1.0f), up = dpp_row_shr<N>(uu[e], 0.0f); uu[e] = a[e] * up + uu[e]; a[e] = a[e] * ap; } }
__device__ __forceinline__ void scan16(f32x4& a, f32x4& uu) {
    float a0 = a.x, a1 = a.y, a2 = a.z, a3 = a.w, u0 = uu.x, u1 = uu.y, u2 = uu.z, u3 = uu.w;
#define SC_STEP(N) \
        "v_fmac_f32_dpp %4, %4, %0 row_shr:" #N " row_mask:0xf bank_mask:0xf\n\t" "v_fmac_f32_dpp %5, %5, %1 row_shr:" #N " row_mask:0xf bank_mask:0xf\n\t" \
        "v_fmac_f32_dpp %6, %6, %2 row_shr:" #N " row_mask:0xf bank_mask:0xf\n\t" "v_fmac_f32_dpp %7, %7, %3 row_shr:" #N " row_mask:0xf bank_mask:0xf\n\t" \
        "v_mul_f32_dpp %0, %0, %0 row_shr:" #N " row_mask:0xf bank_mask:0xf\n\t" "v_mul_f32_dpp %1, %1, %1 row_shr:" #N " row_mask:0xf bank_mask:0xf\n\t" \
        "v_mul_f32_dpp %2, %2, %2 row_shr:" #N " row_mask:0xf bank_mask:0xf\n\t" "v_mul_f32_dpp %3, %3, %3 row_shr:" #N " row_mask:0xf bank_mask:0xf\n\t"
    asm volatile("s_nop 1\n\t" SC_STEP(1) SC_STEP(2) SC_STEP(4) SC_STEP(8) : "+v"(a0), "+v"(a1), "+v"(a2), "+v"(a3), "+v"(u0), "+v"(u1), "+v"(u2), "+v"(u3));
#undef SC_STEP
    a = (f32x4){a0, a1, a2, a3}; uu = (f32x4){u0, u1, u2, u3};
}
struct EpiGateScan {
    static constexpr bool PREF = false;
    const bf16_t* XC; bf16_t* CP; bf16_t* HL; float* PS; float* HS; const float* br; const float* bi; const float* sp8;
    __device__ __forceinline__ void operator()(const Acc& acc, const Unit& u, int wr, int wc, int fr, int fq) const {
        const int row0 = u.pm * BM + wr * 64 + fr;
        const int c0 = (u.pn >> 1) * 256 + (u.pn & 1) * 128 + wc * 32 + 8 * fq;
        const int baddr = ((fq * 16) | 15) * 4;
        f32x4 b_r[2], b_i[2], sp[2];
#pragma unroll
        for (int nh = 0; nh < 2; ++nh) { b_r[nh] = *(const f32x4*)(br + c0 + 4 * nh); b_i[nh] = *(const f32x4*)(bi + c0 + 4 * nh); sp[nh] = *(const f32x4*)(sp8 + c0 + 4 * nh); }
#pragma unroll
        for (int ai = 0; ai < 2; ++ai) {
            u32x4 xw[4];
#pragma unroll
            for (int m = 0; m < 4; ++m) xw[m] = *(const u32x4*)(XC + (unsigned)(row0 + ai * HALF + m * 16) * DM + c0);
            EPI_FENCE();
            f32x4 Ac[2], Hc[2], cp[2], hl[2];
#pragma unroll
            for (int nh = 0; nh < 2; ++nh) { Ac[nh] = (f32x4){1.f, 1.f, 1.f, 1.f}; Hc[nh] = (f32x4){0.f, 0.f, 0.f, 0.f}; }
#pragma unroll
            for (int m = 0; m < 4; ++m) { const unsigned off = (unsigned)(row0 + ai * HALF + m * 16) * DM + c0;
#pragma unroll
                for (int nh = 0; nh < 2; ++nh) {
                    const f32x4 xc = nh == 0 ? unpack4v((u32x2){xw[m].x, xw[m].y}) : unpack4v((u32x2){xw[m].z, xw[m].w});
                    const f32x4 r = sigm4(acc[ai][0][m][nh] + b_r[nh]), ig = sigm4(acc[ai][1][m][nh] + b_i[nh]);
                    const f32x4 lg = -(r * sp[nh]);
                    f32x4 a = exp2n4(-lg);
                    const f32x4 om = 1.0f - a * a;
                    f32x4 s; s.x = __builtin_amdgcn_sqrtf(om.x); s.y = __builtin_amdgcn_sqrtf(om.y); s.z = __builtin_amdgcn_sqrtf(om.z); s.w = __builtin_amdgcn_sqrtf(om.w);
                    f32x4 uu = s * ig * xc;
                    scan16(a, uu);
                    cp[nh] = Ac[nh] * a; hl[nh] = uu + a * Hc[nh];
                    if (m < 3) {
#pragma unroll
                        for (int e = 0; e < 4; ++e) { Ac[nh][e] = __int_as_float(__builtin_amdgcn_update_dpp(0, __float_as_int(cp[nh][e]), 0x15F, 0xf, 0xf, false)); Hc[nh][e] = __int_as_float(__builtin_amdgcn_update_dpp(0, __float_as_int(hl[nh][e]), 0x15F, 0xf, 0xf, false)); } }
                }
                const u32x2 q0 = pack4(cp[0]), q1 = pack4(cp[1]), h0 = pack4(hl[0]), h1 = pack4(hl[1]);
                *(u32x4*)(CP + off) = (u32x4){q0.x, q0.y, q1.x, q1.y}; *(u32x4*)(HL + off) = (u32x4){h0.x, h0.y, h1.x, h1.y}; }
            if (fr == 15) { const size_t t = (size_t)(u.pm * 4 + ai * 2 + wr) * DM + c0;
                *(f32x4*)(PS + t) = cp[0]; *(f32x4*)(PS + t + 4) = cp[1]; *(f32x4*)(HS + t) = hl[0]; *(f32x4*)(HS + t + 4) = hl[1]; }
            EPI_FENCE();
        }
    }
};
struct EpiRes {
    static constexpr bool PREF = false;
    const bf16_t* xin; bf16_t* xout; float* ssq;
    __device__ __forceinline__ void operator()(const Acc& acc, const Unit& u, int wr, int wc, int fr, int fq) const {
        const int row0 = u.pm * BM + wr * 64 + fr; const int col0 = u.pn * BM + wc * 32 + 8 * fq;
#pragma unroll
        for (int ai = 0; ai < 2; ++ai) {
            u32x4 xw[4][2];
#pragma unroll
            for (int m = 0; m < 4; ++m)
#pragma unroll
                for (int bj = 0; bj < 2; ++bj) xw[m][bj] = *(const u32x4*)(xin + (unsigned)(row0 + ai * HALF + m * 16) * DM + col0 + bj * HALF);
            EPI_FENCE();
#pragma unroll
            for (int m = 0; m < 4; ++m) { const int row = row0 + ai * HALF + m * 16; float ss = 0.f;
#pragma unroll
                for (int bj = 0; bj < 2; ++bj) { const unsigned off = (unsigned)row * DM + col0 + bj * HALF;
                    const f32x4 v0 = unpack4v((u32x2){xw[m][bj].x, xw[m][bj].y}) + acc[ai][bj][m][0], v1 = unpack4v((u32x2){xw[m][bj].z, xw[m][bj].w}) + acc[ai][bj][m][1];
                    const f32x4 q = v0 * v0 + v1 * v1; ss += (q.x + q.y) + (q.z + q.w);
                    const u32x2 p0 = pack4(v0), p1 = pack4(v1); *(u32x4*)(xout + off) = (u32x4){p0.x, p0.y, p1.x, p1.y}; }
                ss += __shfl_xor(ss, 16); ss += __shfl_xor(ss, 32);
                if (fq == 0) ssq[(size_t)row * 16 + u.pn * 4 + wc] = ss; }
            EPI_FENCE();
        }
    }
};
struct EpiPle {
    static constexpr bool PREF = true;
    const bf16_t* xin; bf16_t* xout; const bf16_t* E; const float* ssq; float* ssq_out; const LAS float* tab;
    __device__ __forceinline__ void operator()(const Acc& acc, const Unit& u, int wr, int wc, int fr, int fq) const {
        const int row0 = u.pm * BM + wr * 64 + fr; const int col0 = u.pn * BM + wc * 32 + 8 * fq;
        float rsv[2][4];
#pragma unroll
        for (int ai = 0; ai < 2; ++ai)
#pragma unroll
            for (int m = 0; m < 4; ++m) rsv[ai][m] = row_rstd_lds(tab, wr * 64 + fr + ai * HALF + m * 16, fq);
        EPI_FENCE();
#pragma unroll
        for (int ai = 0; ai < 2; ++ai)
#pragma unroll
            for (int mh = 0; mh < 4; mh += 2) {
                u32x4 xw[2][2], ew[2][2];
#pragma unroll
                for (int m = 0; m < 2; ++m)
#pragma unroll
                    for (int bj = 0; bj < 2; ++bj) { const unsigned off = (unsigned)(row0 + ai * HALF + (mh + m) * 16) * DM + col0 + bj * HALF; xw[m][bj] = *(const u32x4*)(xin + off); ew[m][bj] = *(const u32x4*)(E + off); }
                EPI_FENCE();
#pragma unroll
                for (int m = 0; m < 2; ++m) { const int row = row0 + ai * HALF + (mh + m) * 16; const float rs = rsv[ai][mh + m]; float ss = 0.f;
#pragma unroll
                    for (int bj = 0; bj < 2; ++bj) { const unsigned off = (unsigned)row * DM + col0 + bj * HALF;
                        const f32x4 v0 = unpack4v((u32x2){xw[m][bj].x, xw[m][bj].y}) + sigm4(acc[ai][bj][mh + m][0] * rs) * unpack4v((u32x2){ew[m][bj].x, ew[m][bj].y});
                        const f32x4 v1 = unpack4v((u32x2){xw[m][bj].z, xw[m][bj].w}) + sigm4(acc[ai][bj][mh + m][1] * rs) * unpack4v((u32x2){ew[m][bj].z, ew[m][bj].w});
                        const f32x4 q = v0 * v0 + v1 * v1; ss += (q.x + q.y) + (q.z + q.w);
                        const u32x2 p0 = pack4(v0), p1 = pack4(v1); *(u32x4*)(xout + off) = (u32x4){p0.x, p0.y, p1.x, p1.y}; }
                    ss += __shfl_xor(ss, 16); ss += __shfl_xor(ss, 32);
                    if (fq == 0) ssq_out[(size_t)row * 16 + u.pn * 4 + wc] = ss; }
                EPI_FENCE();
            }
    }
};
struct EpiSwi {
    static constexpr bool PREF = true;
    bf16_t* ACT; const float* ssq; const LAS float* tab;
    __device__ __forceinline__ void operator()(const Acc& acc, const Unit& u, int wr, int wc, int fr, int fq) const {
        const int row0 = u.pm * BM + wr * 64 + fr; const int col0 = u.pn * 128 + wc * 32 + 8 * fq;
        float rsv[2][4];
#pragma unroll
        for (int ai = 0; ai < 2; ++ai)
#pragma unroll
            for (int m = 0; m < 4; ++m) rsv[ai][m] = row_rstd_lds(tab, wr * 64 + fr + ai * HALF + m * 16, fq);
        EPI_FENCE();
#pragma unroll
        for (int ai = 0; ai < 2; ++ai)
#pragma unroll
            for (int m = 0; m < 4; ++m) { const int row = row0 + ai * HALF + m * 16; const float rs = rsv[ai][m];
                const f32x4 g0 = acc[ai][0][m][0] * rs, g1 = acc[ai][0][m][1] * rs;
                const u32x2 p0 = pack4(g0 * sigm4(g0) * (acc[ai][1][m][0] * rs)), p1 = pack4(g1 * sigm4(g1) * (acc[ai][1][m][1] * rs));
                *(u32x4*)(ACT + (size_t)row * DFF + col0) = (u32x4){p0.x, p0.y, p1.x, p1.y}; EPI_FENCE(); }
    }
};
struct EpiBf {
    static constexpr bool PREF = false;
    bf16_t* O; int ldc;
    __device__ __forceinline__ void operator()(const Acc& acc, const Unit& u, int wr, int wc, int fr, int fq) const {
        const int row0 = u.pm * BM + wr * 64 + fr; const int col0 = u.pn * BM + wc * 32 + 8 * fq;
#pragma unroll
        for (int ai = 0; ai < 2; ++ai)
#pragma unroll
            for (int m = 0; m < 4; ++m) { const int row = row0 + ai * HALF + m * 16;
#pragma unroll
                for (int bj = 0; bj < 2; ++bj) { float v[8];
#pragma unroll
                    for (int e = 0; e < 8; ++e) v[e] = acc[ai][bj][m][e >> 2][e & 3];
                    *(u32x4*)(O + (size_t)row * ldc + col0 + bj * HALF) = pack8(v); } EPI_FENCE(); }
    }
};

template <int K, int LDA, int LDB, int ACS, int KREP = 1, class Epi>
__device__ __forceinline__ void gemm_phase(LAS unsigned char* lds, const int tid, const Gemm g, const StaticOrder& S, const Epi& E) {
    const int wid = __builtin_amdgcn_readfirstlane(tid >> 6), lane = tid & 63, wr = wid >> 2, wc = wid & 3, fr = lane & 15, fq = lane >> 4;
    constexpr int nt = K / BK;
    unsigned voffA[2], voffB[2];
#pragma unroll
    for (int i = 0; i < 2; ++i) { int R, C; stage_rc(tid * 16 + i * 8192, R, C); const int Rb = (R & ~31) + perm32(R & 31);
        voffA[i] = (unsigned)(R * LDA + C) * 2u; voffB[i] = (unsigned)(Rb * LDB + C) * 2u; }
    constexpr size_t kstep = (size_t)(BK * 2);
    constexpr size_t hstepA = (size_t)HALF * LDA * 2, hstepB = (size_t)HALF * LDB * 2;
    constexpr size_t tstepA = 2 * hstepA, tstepB = 2 * hstepB;
    const unsigned ldsw = (unsigned)wid * 1024u;
    const int aoff = lds_byte(wr * 64 + fr, fq * 8), boff = lds_byte(wc * 32 + fr, fq * 8);
#define PG8_SA(b, h) (((b) * 2 + (h)) * HTB)
#define PG8_SB(b, h) ((4 + (b) * 2 + (h)) * HTB)
#define PG8_STAGE(bufoff, gbase, voff) do { _Pragma("unroll") for (int _i = 0; _i < 2; ++_i) \
        __builtin_amdgcn_global_load_lds((const unsigned*)((const char*)(gbase) + (voff)[_i]), (LAS unsigned*)(lds + (bufoff) + ldsw + _i * 8192), 16, 0, 0); } while (0)
#define PG8_LDA(dst, b, h) do { _Pragma("unroll") for (int m = 0; m < 4; ++m) _Pragma("unroll") for (int k = 0; k < 2; ++k) dst[m][k] = *(const LAS bf16x8*)(lds + PG8_SA(b, h) + aoff + m * 2048 + k * 1024); } while (0)
#define PG8_LDB(dst, b, h) do { _Pragma("unroll") for (int n = 0; n < 2; ++n) _Pragma("unroll") for (int k = 0; k < 2; ++k) dst[n][k] = *(const LAS bf16x8*)(lds + PG8_SB(b, h) + boff + n * 2048 + k * 1024); } while (0)
#define PG8_MMA(ai, bj, At, Bt) do { __builtin_amdgcn_s_setprio(1); _Pragma("unroll") for (int m = 0; m < 4; ++m) _Pragma("unroll") for (int n = 0; n < 2; ++n) _Pragma("unroll") for (int k = 0; k < 2; ++k) \
        acc[ai][bj][m][n] = __builtin_amdgcn_mfma_f32_16x16x32_bf16(Bt[n][k], At[m][k], acc[ai][bj][m][n], 0, 0, 0); __builtin_amdgcn_s_setprio(0); } while (0)
#define PG8_WAIT_V(n) asm volatile("s_waitcnt vmcnt(" #n ")" ::: "memory")
#define PG8_WAIT_L(n) asm volatile("s_waitcnt lgkmcnt(" #n ")" ::: "memory")
#define PG8_BAR __builtin_amdgcn_s_barrier()
#define PG8_SCHED __builtin_amdgcn_sched_barrier(0)
    Unit cur, nxt; int ui = 0;
    if (!S.next(0, cur)) return;
    Acc acc;
#pragma unroll
    for (int a = 0; a < 2; ++a)
#pragma unroll
        for (int b = 0; b < 2; ++b)
#pragma unroll
            for (int m = 0; m < 4; ++m)
#pragma unroll
                for (int n = 0; n < 2; ++n) acc[a][b][m][n] = (f32x4){0.f, 0.f, 0.f, 0.f};
    bf16x8 At[4][2], B0[2][2], B1[2][2];
    const char* cA = (const char*)g.A + (size_t)cur.pm * tstepA + (size_t)((cur.pn >> 1) * ACS) * 2; const char* cB = (const char*)g.Bt + (size_t)cur.pn * tstepB;
    PG8_STAGE(PG8_SB(0, 0), cB, voffB); PG8_STAGE(PG8_SB(0, 1), cB + hstepB, voffB); PG8_STAGE(PG8_SA(0, 0), cA, voffA); PG8_STAGE(PG8_SA(0, 1), cA + hstepA, voffA);
    if (wr == 1) PG8_BAR;
    PG8_WAIT_V(2); PG8_BAR;
    PG8_STAGE(PG8_SB(1, 0), cB + kstep, voffB); PG8_STAGE(PG8_SA(1, 0), cA + kstep, voffA); PG8_STAGE(PG8_SB(1, 1), cB + hstepB + kstep, voffB);
    PG8_WAIT_V(6); PG8_BAR;
    for (;;) {
        const bool has_next = S.next(ui + 1, nxt);
        const char* nA = has_next ? (const char*)g.A + (size_t)nxt.pm * tstepA + (size_t)((nxt.pn >> 1) * ACS) * 2 : cA; const char* nB = has_next ? (const char*)g.Bt + (size_t)nxt.pn * tstepB : cB;
#pragma unroll 1
        for (int tt = 0; tt < nt * KREP; tt += 2) {
            const int t = (KREP == 1) ? tt : tt % nt;
            const bool last = (t == nt - 2), lastrep = (KREP == 1) || (tt == nt * KREP - 2);
            const char* a1 = cA + (size_t)(t + 1) * kstep;
            const char* a2 = last ? (lastrep ? nA : cA) : cA + (size_t)(t + 2) * kstep; const char* b2 = last ? (lastrep ? nB : cB) : cB + (size_t)(t + 2) * kstep;
            const char* a3 = a2 + kstep; const char* b3 = b2 + kstep;
            PG8_LDB(B0, 0, 0); PG8_LDB(B1, 0, 1); PG8_SCHED; PG8_LDA(At, 0, 0); PG8_STAGE(PG8_SA(1, 1), a1 + hstepA, voffA);
            PG8_WAIT_V(8); PG8_WAIT_L(0); PG8_BAR; PG8_MMA(0, 0, At, B0); PG8_MMA(0, 1, At, B1); PG8_BAR; PG8_SCHED;
            if constexpr (Epi::PREF) { if (tt == 0) {
#pragma unroll
                for (int q_ = 0; q_ < 2; ++q_) { const int p_ = 2 * wc + q_, rl_ = (p_ >> 2) * HALF + wr * 64 + (p_ & 3) * 16;
                    __builtin_amdgcn_global_load_lds((const unsigned*)(E.ssq + ((size_t)cur.pm * BM + rl_) * 16 + lane * 4), (LAS unsigned*)(lds + SSQ_TAB_OFF + rl_ * 64), 16, 0, 0); } }
                PG8_SCHED; }
            PG8_LDA(At, 0, 1); PG8_STAGE(PG8_SB(0, 0), b2, voffB); PG8_STAGE(PG8_SB(0, 1), b2 + hstepB, voffB); PG8_STAGE(PG8_SA(0, 0), a2, voffA);
            PG8_WAIT_V(8); PG8_WAIT_L(0); PG8_BAR; PG8_MMA(1, 0, At, B0); PG8_MMA(1, 1, At, B1); PG8_BAR; PG8_SCHED;
            PG8_LDB(B0, 1, 0); PG8_LDB(B1, 1, 1); PG8_SCHED; PG8_LDA(At, 1, 0); PG8_STAGE(PG8_SA(0, 1), a2 + hstepA, voffA);
            PG8_WAIT_V(8); PG8_WAIT_L(0); PG8_BAR; PG8_MMA(0, 0, At, B0); PG8_MMA(0, 1, At, B1); PG8_BAR; PG8_SCHED;
            PG8_LDA(At, 1, 1); PG8_STAGE(PG8_SB(1, 0), b3, voffB); PG8_STAGE(PG8_SB(1, 1), b3 + hstepB, voffB); PG8_STAGE(PG8_SA(1, 0), a3, voffA);
            PG8_WAIT_V(8); PG8_WAIT_L(0); PG8_BAR; PG8_MMA(1, 0, At, B0); PG8_MMA(1, 1, At, B1); PG8_BAR; PG8_SCHED;
        }
        if (wr == 0) PG8_BAR;
        if constexpr (KREP != 1) {
#pragma unroll
            for (int a = 0; a < 2; ++a)
#pragma unroll
                for (int b = 0; b < 2; ++b)
#pragma unroll
                    for (int m = 0; m < 4; ++m)
#pragma unroll
                        for (int n = 0; n < 2; ++n) acc[a][b][m][n] = acc[a][b][m][n] * (1.0f / KREP);
        }
        E(acc, cur, wr, wc, fr, fq);
        if (!has_next) break;
#pragma unroll
        for (int a = 0; a < 2; ++a)
#pragma unroll
            for (int b = 0; b < 2; ++b)
#pragma unroll
                for (int m = 0; m < 4; ++m)
#pragma unroll
                    for (int n = 0; n < 2; ++n) acc[a][b][m][n] = (f32x4){0.f, 0.f, 0.f, 0.f};
        cur = nxt; cA = nA; cB = nB; ++ui;
        if (wr == 1) PG8_BAR;
    }
    PG8_WAIT_V(0);
    PG8_BAR;
#undef PG8_SA
#undef PG8_SB
#undef PG8_STAGE
#undef PG8_LDA
#undef PG8_LDB
#undef PG8_MMA
#undef PG8_WAIT_V
#undef PG8_WAIT_L
#undef PG8_BAR
#undef PG8_SCHED
}
}

__device__ __forceinline__ void wconv_item(const float* src, int ldsrc, const float* gain, bf16_t* dst, int lddst, LAS float* scr, int lane) {
    float wv[32];
#pragma unroll
    for (int i = 0; i < 32; ++i) { const int kk = 2 * i + (lane >> 5); wv[i] = src[(size_t)kk * ldsrc + (lane & 31)]; }
    if (gain) {
#pragma unroll
        for (int i = 0; i < 32; ++i) wv[i] *= gain[2 * i + (lane >> 5)]; }
#pragma unroll
    for (int i = 0; i < 32; ++i) { const int kk = 2 * i + (lane >> 5); scr[kk * 33 + (lane & 31)] = wv[i]; }
    LDS_WAIT(); asm volatile("" ::: "memory");
    const int c = lane & 7;
#pragma unroll
    for (int j = 0; j < 4; ++j) { const int n = (lane >> 3) + 8 * j; const LAS float* s = scr + (8 * c) * 33 + n;
        u32x4 o; o.x = cvt_pk_bf16(s[0 * 33], s[1 * 33]); o.y = cvt_pk_bf16(s[2 * 33], s[3 * 33]); o.z = cvt_pk_bf16(s[4 * 33], s[5 * 33]); o.w = cvt_pk_bf16(s[6 * 33], s[7 * 33]);
        *(u32x4*)(dst + (size_t)n * lddst + 8 * c) = o; }
    LDS_WAIT(); asm volatile("" ::: "memory");
}
__device__ __forceinline__ int win_src_col(int n0) {
    const int pn = n0 >> 8, rr = n0 & 255;
    if (pn < 4) return n0;
    const int q = (pn - 4) >> 3, j = (pn - 4) & 7, half = rr >> 7, off = rr & 127;
    int base;
    if (q == 0) base = half ? 4096 : 3072;
    else if (q == 1) base = half ? 5120 : 1024;
    else base = half ? 6144 : 2048;
    return base + 128 * j + off;
}


#define XB_TMO      128
#define XB_XCNT(j)  (256  + 64 * (j))
#define XB_XSUB(j)  (1280 + 64 * (j))
#define XB_XGEN(j)  (2304 + 64 * (j))
#define XB_TOP      3328
#define XB_TOPGEN   3392
#define XCD_BAR_WORDS 3456
#define XB_SPIN_CAP (1u << 18)
__device__ __forceinline__ unsigned xb_ld(unsigned* p)              { return __hip_atomic_load(p, __ATOMIC_RELAXED, __HIP_MEMORY_SCOPE_AGENT); }
__device__ __forceinline__ unsigned xb_add(unsigned* p, unsigned v) { return __hip_atomic_fetch_add(p, v, __ATOMIC_RELAXED, __HIP_MEMORY_SCOPE_AGENT); }
__device__ __forceinline__ unsigned xb_xcc_id() { return (unsigned)__builtin_amdgcn_s_getreg((3 << 11) | 20) & 0xFu; }
#define XB_SPIN(cond, bar) do { unsigned _sp = 0; while (cond) { __builtin_amdgcn_s_sleep(1); \
    if ((++_sp & 255u) == 0u) { if (xb_ld(&(bar)[XB_TMO])) break; if (_sp > XB_SPIN_CAP) { atomicAdd(&(bar)[XB_TMO], 1u); break; } } } } while (0)
struct XcdBarrier { unsigned* bar; unsigned x; volatile LAS unsigned* st; };
__device__ __forceinline__ XcdBarrier xcd_barrier_post(unsigned* bar, volatile LAS unsigned* st) {
    XcdBarrier b; b.bar = bar; b.x = xb_xcc_id(); b.st = st;
    if (threadIdx.x == 0) (void)xb_add(&bar[XB_XCNT(b.x)], 1u);
    return b;
}
__device__ __forceinline__ void xcd_barrier_complete(unsigned* bar, unsigned x, unsigned& nloc, unsigned& nx) {
    const unsigned G = gridDim.x * gridDim.y * gridDim.z;
    unsigned sum, cnt, mine, sp = 0u;
    for (;;) {
        sum = 0u; cnt = 0u; mine = 0u;
#pragma unroll
        for (unsigned j = 0; j < 16; ++j) { const unsigned c = xb_ld(&bar[XB_XCNT(j)]); sum += c; cnt += (c > 0u) ? 1u : 0u; mine = (j == x) ? c : mine; }
        if (sum == G) break;
        __builtin_amdgcn_s_sleep(1);
        if ((++sp & 255u) == 0u) { if (xb_ld(&bar[XB_TMO])) break; if (sp > XB_SPIN_CAP) { atomicAdd(&bar[XB_TMO], 1u); break; } }
    }
    nloc = mine > 0u ? mine : 1u; nx = cnt > 0u ? cnt : 1u;
}
__device__ __forceinline__ void xcd_barrier(const XcdBarrier& b, const bool local_only = false, const bool no_release = false) {
    asm volatile("s_waitcnt vmcnt(0)" ::: "memory");
    __syncthreads();
    if (threadIdx.x == 0) {
        unsigned* bar = b.bar;
        __builtin_amdgcn_s_waitcnt(0);
        unsigned nloc = b.st[0], nx = b.st[1];
        if (nloc == 0u) { xcd_barrier_complete(bar, b.x, nloc, nx); b.st[0] = nloc; b.st[1] = nx; }
        const unsigned old = xb_add(&bar[XB_XSUB(b.x)], 1u);
        const unsigned gen = old / nloc;
        if (old + 1u == (gen + 1u) * nloc) {
            if (!local_only) {
                if (!no_release) { __builtin_amdgcn_fence(__ATOMIC_RELEASE, "agent");
                                   asm volatile("s_waitcnt vmcnt(0)" ::: "memory"); }
                const unsigned og = xb_add(&bar[XB_TOP], 1u);
                const unsigned tg = og / nx;
                if (og + 1u == (tg + 1u) * nx) xb_add(&bar[XB_TOPGEN], 1u);
                else XB_SPIN(xb_ld(&bar[XB_TOPGEN]) == tg, bar);
            }
            __builtin_amdgcn_fence(__ATOMIC_ACQUIRE, "agent");
            xb_add(&bar[XB_XGEN(b.x)], 1u);
            asm volatile("s_waitcnt vmcnt(0)" ::: "memory");
        } else {
            XB_SPIN(xb_ld(&bar[XB_XGEN(b.x)]) == gen, bar);
            __builtin_amdgcn_fence(__ATOMIC_ACQUIRE, "agent");
            asm volatile("s_waitcnt vmcnt(0)" ::: "memory");
        }
    }
    __syncthreads();
}


struct Args { const float* in[20]; float* out; unsigned char* ws; int ph_lo, ph_hi; };

struct Ctx {
    const float* const* in; unsigned char* ws; float* X; LAS unsigned char* lds;
    int tid, lane, wave, gtid, NT, gw, NGW, G;
};

__device__ __forceinline__ void conv_early(const Ctx& c, int l) {
    LAS float* scr = (LAS float*)(c.lds + c.wave * 16384);
    bf16_t* WINT = (bf16_t*)(c.ws + WS_WIN); bf16_t* WGT = (bf16_t*)(c.ws + WS_WG);
    const float* w_in = c.in[3] + (size_t)l * DM * WIN; const float* g_mix = c.in[2] + l * DM;
    const float* wr_ = c.in[6] + (size_t)l * 262144; const float* wi_ = c.in[8] + (size_t)l * 262144;
    constexpr int I_WIN = 16 * 224, I_G = 4 * 64;
    for (int it = c.gw; it < I_WIN + I_G; it += c.NGW) {
        if (it < I_WIN) { const int kb = it / 224, nb = it % 224, k0 = 64 * kb, n0 = 32 * nb;
            wconv_item(w_in + (size_t)k0 * WIN + win_src_col(n0), WIN, g_mix + k0, WINT + (size_t)n0 * DM + k0, DM, scr, c.lane); }
        else { const int r = it - I_WIN, kb = r / 64, nb = r % 64, k0 = 64 * kb, n0 = 32 * nb;
            const int h = n0 >> 9, jt = (n0 >> 8) & 1, half = (n0 >> 7) & 1, off = n0 & 127;
            const float* src = (half ? wi_ : wr_) + (size_t)h * 65536 + (size_t)k0 * 256 + 128 * jt + off;
            wconv_item(src, 256, nullptr, WGT + (size_t)n0 * 256 + k0, 256, scr, c.lane); }
    }
}
__device__ __forceinline__ void conv_late(const Ctx& c, int l) {
    LAS float* scr = (LAS float*)(c.lds + c.wave * 16384);
    bf16_t* WOUT = (bf16_t*)(c.ws + WS_WOUT); bf16_t* WGU = (bf16_t*)(c.ws + WS_WGU); bf16_t* WDN = (bf16_t*)(c.ws + WS_WDN); bf16_t* WPG = (bf16_t*)(c.ws + WS_WPG); bf16_t* WPLE = (bf16_t*)(c.ws + WS_WPLE);
    const float* w_out = c.in[12] + (size_t)l * DM * DM; const float* g_ffn = c.in[13] + l * DM; const float* w_gu = c.in[14] + (size_t)l * DM * 2 * DFF;
    const float* w_dn = c.in[15] + (size_t)l * DFF * DM; const float* g_ple = c.in[16] + l * DM; const float* w_pg = c.in[17] + (size_t)l * DM * DM; const float* w_ple = c.in[18] + (size_t)l * PLE * DM;
    constexpr int I_O = 16 * 32, I_GU = 16 * 176, I_DN = 44 * 32, I_PG = 16 * 32, I_PL = 4 * 32;
    for (int it = c.gw; it < I_O + I_GU + I_DN + I_PG + I_PL; it += c.NGW) {
        int r = it;
        if (r < I_O) { const int kb = r / 32, nb = r % 32, k0 = 64 * kb, n0 = 32 * nb; wconv_item(w_out + (size_t)k0 * DM + n0, DM, nullptr, WOUT + (size_t)n0 * DM + k0, DM, scr, c.lane); continue; } r -= I_O;
        if (r < I_GU) { const int kb = r / 176, nb = r % 176, k0 = 64 * kb, n0 = 32 * nb; const int pn = n0 >> 8, half = (n0 >> 7) & 1, off = n0 & 127;
            wconv_item(w_gu + (size_t)k0 * (2 * DFF) + half * DFF + 128 * pn + off, 2 * DFF, g_ffn + k0, WGU + (size_t)n0 * DM + k0, DM, scr, c.lane); continue; } r -= I_GU;
        if (r < I_DN) { const int kb = r / 32, nb = r % 32, k0 = 64 * kb, n0 = 32 * nb; wconv_item(w_dn + (size_t)k0 * DM + n0, DM, nullptr, WDN + (size_t)n0 * DFF + k0, DFF, scr, c.lane); continue; } r -= I_DN;
        if (r < I_PG) { const int kb = r / 32, nb = r % 32, k0 = 64 * kb, n0 = 32 * nb; wconv_item(w_pg + (size_t)k0 * DM + n0, DM, g_ple + k0, WPG + (size_t)n0 * DM + k0, DM, scr, c.lane); continue; } r -= I_PG;
        { const int kb = r / 32, nb = r % 32, k0 = 64 * kb, n0 = 32 * nb; wconv_item(w_ple + (size_t)k0 * DM + n0, DM, nullptr, WPLE + (size_t)n0 * PLE + k0, PLE, scr, c.lane); }
    }
    const float* p = c.in[1] + (size_t)l * M * PLE; bf16_t* PB = (bf16_t*)(c.ws + WS_PB);
    for (int it0 = c.gtid; it0 < M * PLE / 8; it0 += 4 * c.NT) {
        f32x4 a[4], b[4];
#pragma unroll
        for (int q = 0; q < 4; ++q) { const int it = it0 + q * c.NT; if (it < M * PLE / 8) { a[q] = *(const f32x4*)(p + (size_t)it * 8); b[q] = *(const f32x4*)(p + (size_t)it * 8 + 4); } }
#pragma unroll
        for (int q = 0; q < 4; ++q) { const int it = it0 + q * c.NT; if (it < M * PLE / 8) {
            u32x4 w; w.x = cvt_pk_bf16(a[q].x, a[q].y); w.y = cvt_pk_bf16(a[q].z, a[q].w); w.z = cvt_pk_bf16(b[q].x, b[q].y); w.w = cvt_pk_bf16(b[q].z, b[q].w); *(u32x4*)(PB + (size_t)it * 8) = w; } }
    }
}

__device__ __forceinline__ float wave_sum(float v) {
#pragma unroll
    for (int o = 1; o < 64; o <<= 1) v += __shfl_xor(v, o);
    return v;
}

__device__ __forceinline__ void prologue(const Ctx& c) {
    const float* x = c.in[0]; bf16_t* XB = (bf16_t*)c.X; float* ssq1 = (float*)(c.ws + WS_SSQ1);
    for (int m0 = c.gw * 4; m0 < M; m0 += c.NGW * 4) {
        f32x4 v[4][4];
#pragma unroll
        for (int r = 0; r < 4; ++r) { const f32x4* xr = (const f32x4*)(x + (size_t)(m0 + r) * DM) + c.lane;
#pragma unroll
            for (int j = 0; j < 4; ++j) v[r][j] = xr[64 * j]; }
#pragma unroll
        for (int r = 0; r < 4; ++r) { const int m = m0 + r; float s = 0.f;
#pragma unroll
            for (int j = 0; j < 4; ++j) s += (v[r][j].x * v[r][j].x + v[r][j].y * v[r][j].y) + (v[r][j].z * v[r][j].z + v[r][j].w * v[r][j].w);
            s = wave_sum(s);
            u32x2* o = (u32x2*)(XB + (size_t)m * DM) + c.lane;
#pragma unroll
            for (int j = 0; j < 4; ++j) { u32x2 w; w.x = cvt_pk_bf16(v[r][j].x, v[r][j].y); w.y = cvt_pk_bf16(v[r][j].z, v[r][j].w); o[64 * j] = w; }
            if (c.lane < 16) ssq1[(size_t)m * 16 + c.lane] = (c.lane == 0) ? s : 0.f; }
    }
    float* sp8 = (float*)(c.ws + WS_SP8); const float* lam = c.in[10];
    for (int i = c.gtid; i < DEPTH * DM; i += c.NT) sp8[i] = 8.0f * log1pf(expf(-lam[i]));
    conv_early(c, 0);
}

__device__ __forceinline__ void conv4_phase(const Ctx& c, int l, unsigned vcu, bool xcd_local) {
    const bf16_t* RX = (const bf16_t*)(c.ws + WS_RX); bf16_t* XC = (bf16_t*)(c.ws + WS_XC);
    const float* w4 = c.in[4] + (size_t)l * 4 * DM; const float* b4 = c.in[5] + l * DM;
    const int nit = xcd_local ? 4 : ((M / 8) * 128 + c.NT - 1) / c.NT;
    for (int it_ = 0; it_ < nit; ++it_) {
        const int item = xcd_local ? (int)(vcu & 7u) * 65536 + (int)(vcu >> 3) * 512 + c.tid + 16384 * it_ : c.gtid + it_ * c.NT;
        if (item >= (M / 8) * 128) break;
        const int run = item >> 7, c0 = (item & 127) * 8, t0 = run * 8;
        float w[4][8], b[8];
#pragma unroll
        for (int k = 0; k < 4; ++k) { const f32x4 a = *(const f32x4*)(w4 + k * DM + c0), bb = *(const f32x4*)(w4 + k * DM + c0 + 4);
            w[k][0] = a.x; w[k][1] = a.y; w[k][2] = a.z; w[k][3] = a.w; w[k][4] = bb.x; w[k][5] = bb.y; w[k][6] = bb.z; w[k][7] = bb.w; }
        { const f32x4 a = *(const f32x4*)(b4 + c0), bb = *(const f32x4*)(b4 + c0 + 4); b[0] = a.x; b[1] = a.y; b[2] = a.z; b[3] = a.w; b[4] = bb.x; b[5] = bb.y; b[6] = bb.z; b[7] = bb.w; }
        float h0[8], h1[8], h2[8];
        if ((t0 & (SEQ - 1)) == 0) {
#pragma unroll
            for (int e = 0; e < 8; ++e) { h0[e] = 0.f; h1[e] = 0.f; h2[e] = 0.f; }
        } else {
            unpack8(*(const u32x4*)(RX + (size_t)(t0 - 3) * DM + c0), h0); unpack8(*(const u32x4*)(RX + (size_t)(t0 - 2) * DM + c0), h1); unpack8(*(const u32x4*)(RX + (size_t)(t0 - 1) * DM + c0), h2);
        }
        u32x4 wrow[8];
#pragma unroll
        for (int i = 0; i < 8; ++i) wrow[i] = *(const u32x4*)(RX + (size_t)(t0 + i) * DM + c0);
#pragma unroll
        for (int i = 0; i < 8; ++i) { float f[8], o[8]; unpack8(wrow[i], f);
#pragma unroll
            for (int e = 0; e < 8; ++e) { o[e] = b[e] + w[0][e] * h0[e] + w[1][e] * h1[e] + w[2][e] * h2[e] + w[3][e] * f[e]; h0[e] = h1[e]; h1[e] = h2[e]; h2[e] = f[e]; }
            *(u32x4*)(XC + (size_t)(t0 + i) * DM + c0) = pack8(o); }
    }
}

__device__ __forceinline__ void scan_local(const Ctx& c, int l) {
    bf16_t* PR = (bf16_t*)(c.ws + WS_RX); bf16_t* PI = (bf16_t*)(c.ws + WS_U); const bf16_t* XC = (const bf16_t*)(c.ws + WS_XC);
    float* PS = (float*)(c.ws + WS_PS); float* HS = (float*)(c.ws + WS_HS); const float* sp8 = (const float*)(c.ws + WS_SP8) + l * DM;
    for (int item = c.gtid; item < NCHUNK * 256; item += c.NT) {
        const int chunk = item >> 8, c0 = (item & 255) * 4;
        const f32x4 sp = *(const f32x4*)(sp8 + c0);
        f32x4 hl = (f32x4){0.f, 0.f, 0.f, 0.f}, cp = (f32x4){1.f, 1.f, 1.f, 1.f};
        const size_t base = (size_t)chunk * LCH * DM + c0;
        u32x2 nr_[8], ni_[8], nx_[8];
#pragma unroll
        for (int j = 0; j < 8; ++j) { const size_t o = base + (size_t)j * DM; nr_[j] = *(const u32x2*)(PR + o); ni_[j] = *(const u32x2*)(PI + o); nx_[j] = *(const u32x2*)(XC + o); }
#pragma unroll 1
        for (int tb = 0; tb < LCH; tb += 8) {
            u32x2 wr_[8], wi_[8], wx_[8];
#pragma unroll
            for (int j = 0; j < 8; ++j) { wr_[j] = nr_[j]; wi_[j] = ni_[j]; wx_[j] = nx_[j]; }
            if (tb + 8 < LCH) {
#pragma unroll
                for (int j = 0; j < 8; ++j) { const size_t o = base + (size_t)(tb + 8 + j) * DM; nr_[j] = *(const u32x2*)(PR + o); ni_[j] = *(const u32x2*)(PI + o); nx_[j] = *(const u32x2*)(XC + o); } }
#pragma unroll
            for (int j = 0; j < 8; ++j) {
                const f32x4 pr = unpack4v(wr_[j]), pi = unpack4v(wi_[j]), xc = unpack4v(wx_[j]);
                const f32x4 r = sigm4(pr), ig = sigm4(pi);
                const f32x4 lg = -(r * sp), x2 = lg + lg;
                f32x4 em = x2 * (x2 * (x2 * (x2 * (x2 * (x2 * 0.0013888889f + 0.0083333338f) + 0.041666668f) + 0.16666667f) + 0.5f) + 1.0f);
                if (__builtin_amdgcn_ballot_w64((x2.x <= -0.25f) | (x2.y <= -0.25f) | (x2.z <= -0.25f) | (x2.w <= -0.25f)) != 0ull) {
#pragma unroll
                    for (int e = 0; e < 4; ++e) if (x2[e] <= -0.25f) em[e] = __expf(x2[e]) - 1.f; }
                f32x4 s; s.x = __builtin_amdgcn_sqrtf(-em.x); s.y = __builtin_amdgcn_sqrtf(-em.y); s.z = __builtin_amdgcn_sqrtf(-em.z); s.w = __builtin_amdgcn_sqrtf(-em.w);
                const f32x4 a = exp2n4(-lg), uu = s * ig * xc;
                hl = a * hl + uu; cp = cp * a;
                const size_t o = base + (size_t)(tb + j) * DM;
                *(u32x2*)(PI + o) = pack4(hl); *(u32x2*)(PR + o) = pack4(cp); }
        }
        *(f32x4*)(PS + (size_t)chunk * DM + c0) = cp; *(f32x4*)(HS + (size_t)chunk * DM + c0) = hl;
    }
}
__device__ __forceinline__ void merge_phase(const Ctx& c, int l, unsigned bx) {
    const bf16_t* CP = (const bf16_t*)c.X + (size_t)M * DM; const bf16_t* HL = (const bf16_t*)(c.ws + WS_U); const bf16_t* CX = (const bf16_t*)(c.ws + WS_CX);
    const bf16_t* GY = (const bf16_t*)(c.ws + WS_GY); const bf16_t* GB = (const bf16_t*)(c.ws + WS_GB); bf16_t* MG = (bf16_t*)(c.ws + WS_XC);
    const float* PS = (const float*)(c.ws + WS_PS); const float* HS = (const float*)(c.ws + WS_HS); const float* w3 = c.in[11] + (size_t)l * 3 * DM;
    LAS float* carr = (LAS float*)c.lds;
    constexpr int CPS = SEQ / LCH;
    for (int rb = (int)bx; rb < M / 128; rb += c.G) {
        const int k0 = 2 * rb, kk0 = k0 % CPS, kbase = k0 - kk0;
        { const int c2 = 2 * c.tid; f32x2 carry = (f32x2){0.f, 0.f};
#pragma unroll 1
          for (int k = 0; k < kk0; k += 32) {
              f32x2 P[32], H[32];
#pragma unroll
              for (int j = 0; j < 32; ++j) { const int kc = (k + j < kk0) ? (k + j) : (kk0 - 1); P[j] = *(const f32x2*)(PS + (size_t)(kbase + kc) * DM + c2); H[j] = *(const f32x2*)(HS + (size_t)(kbase + kc) * DM + c2); }
#pragma unroll
              for (int j = 0; j < 32; ++j) { if (k + j < kk0) carry = P[j] * carry + H[j]; } }
          const f32x2 P = *(const f32x2*)(PS + (size_t)k0 * DM + c2), H = *(const f32x2*)(HS + (size_t)k0 * DM + c2);
          const f32x2 carry1 = P * carry + H;
          carr[c2] = carry.x; carr[c2 + 1] = carry.y; carr[DM + c2] = carry1.x; carr[DM + c2 + 1] = carry1.y; }
        __syncthreads();
#pragma unroll 1
        for (int it = 0; it < 4; ++it) {
            const int item = c.tid + 512 * it, run = item >> 7, c0 = (item & 127) * 8, t0 = rb * 128 + run * 8;
            float w[3][8], cr[8];
#pragma unroll
            for (int k = 0; k < 3; ++k) { const f32x4 a = *(const f32x4*)(w3 + k * DM + c0), bb = *(const f32x4*)(w3 + k * DM + c0 + 4);
                w[k][0] = a.x; w[k][1] = a.y; w[k][2] = a.z; w[k][3] = a.w; w[k][4] = bb.x; w[k][5] = bb.y; w[k][6] = bb.z; w[k][7] = bb.w; }
            { const LAS f32x4* cp4 = (const LAS f32x4*)(carr + (run >> 3) * DM + c0); const f32x4 a = cp4[0], bb = cp4[1]; cr[0] = a.x; cr[1] = a.y; cr[2] = a.z; cr[3] = a.w; cr[4] = bb.x; cr[5] = bb.y; cr[6] = bb.z; cr[7] = bb.w; }
            float p0[8], p1[8];
            if ((t0 & (SEQ - 1)) == 0) {
#pragma unroll
                for (int e = 0; e < 8; ++e) { p0[e] = 0.f; p1[e] = 0.f; }
            } else { unpack8(*(const u32x4*)(CX + (size_t)(t0 - 2) * DM + c0), p0); unpack8(*(const u32x4*)(CX + (size_t)(t0 - 1) * DM + c0), p1); }
#pragma unroll
            for (int ib = 0; ib < 8; ib += 4) {
                u32x4 whl[4], wcp[4], wgy[4], wgb[4], wcx[4];
#pragma unroll
                for (int i = 0; i < 4; ++i) { const size_t off = (size_t)(t0 + ib + i) * DM + c0;
                    whl[i] = *(const u32x4*)(HL + off); wcp[i] = *(const u32x4*)(CP + off); wgy[i] = *(const u32x4*)(GY + off); wgb[i] = *(const u32x4*)(GB + off); wcx[i] = *(const u32x4*)(CX + off); }
#pragma unroll
                for (int i = 0; i < 4; ++i) { const size_t off = (size_t)(t0 + ib + i) * DM + c0;
                    float hl[8], cp[8], gy[8], gb[8], cx[8], o[8];
                    unpack8(whl[i], hl); unpack8(wcp[i], cp); unpack8(wgy[i], gy); unpack8(wgb[i], gb); unpack8(wcx[i], cx);
#pragma unroll
                    for (int e = 0; e < 8; ++e) { const float h = hl[e] + cp[e] * cr[e]; o[e] = gy[e] * h + gb[e] * (w[0][e] * p0[e] + w[1][e] * p1[e] + w[2][e] * cx[e]); p0[e] = p1[e]; p1[e] = cx[e]; }
                    *(u32x4*)(MG + off) = pack8(o); }
            }
        }
        __syncthreads();
    }
}
__device__ __forceinline__ void final_phase(const Ctx& c) {
    const float* ssq = (const float*)(c.ws + WS_SSQ1); const float* g = c.in[19]; const bf16_t* xl = (const bf16_t*)(c.ws + WS_XC);
    f32x4 gv[4];
#pragma unroll
    for (int j = 0; j < 4; ++j) gv[j] = ((const f32x4*)g)[c.lane + 64 * j];
    for (int m0 = c.gw * 4; m0 < M; m0 += c.NGW * 4) {
        u32x2 xw[4][4]; float rs[4];
#pragma unroll
        for (int r = 0; r < 4; ++r) { const u32x2* xr = (const u32x2*)(xl + (size_t)(m0 + r) * DM) + c.lane; rs[r] = row_rstd(ssq, m0 + r);
#pragma unroll
            for (int j = 0; j < 4; ++j) xw[r][j] = xr[64 * j]; }
#pragma unroll
        for (int r = 0; r < 4; ++r) { f32x4* orow = (f32x4*)((float*)c.X + (size_t)(m0 + r) * DM) + c.lane;
#pragma unroll
            for (int j = 0; j < 4; ++j) orow[64 * j] = unpack4v(xw[r][j]) * rs[r] * gv[j]; }
    }
}

__global__ void __launch_bounds__(512, 2) fwd_mega(Args a) {
    extern __shared__ __attribute__((aligned(16))) unsigned char lds_raw[];
    cg::grid_group grid = cg::this_grid();
    volatile LAS unsigned* bst = (volatile LAS unsigned*)((LAS unsigned char*)lds_raw + RING_BYTES + 256);
    if (threadIdx.x < 8) bst[threadIdx.x] = 0u;
    __syncthreads();
    const XcdBarrier xbar = xcd_barrier_post((unsigned*)(a.ws + WS_BAR), bst);
    unsigned* xcnt = (unsigned*)(a.ws + WS_BAR) + 3584;
    if (threadIdx.x == 0) bst[4] = xb_add(&xcnt[64 * xbar.x], 1u);
    __syncthreads();
    const unsigned my_rank = (unsigned)__builtin_amdgcn_readfirstlane((int)bst[4]);
    unsigned vcu = blockIdx.x; bool vcu_known = false;
#ifndef LOCAL_SEAMS
#define LOCAL_SEAMS 1
#endif
#ifndef KREP_WIN
#define KREP_WIN 1
#endif
#ifndef DUPMASK
#define DUPMASK 0
#endif
#ifndef EXTRA_SYNCS
#define EXTRA_SYNCS 0
#endif
    bool dup_done = false;
    for (int ph = a.ph_lo; ph < a.ph_hi; ++ph) {
        if (!vcu_known && ph > a.ph_lo) {
            bool ok = (gridDim.x % 8u) == 0u;
            for (unsigned j = 0; j < 8; ++j) ok = ok && ((unsigned)__builtin_amdgcn_readfirstlane((int)xb_ld(&xcnt[64 * j])) == gridDim.x / 8u);
            if (ok && xbar.x < 8u && my_rank < gridDim.x / 8u) vcu = my_rank * 8u + xbar.x;
            if (threadIdx.x == 0) bst[5] = ok ? 1u : 0u;
            vcu_known = true;
        }
        int tid_ = threadIdx.x; unsigned bx_ = vcu; size_t zoff_ = 0;
        asm volatile("" : "+v"(tid_)); asm volatile("" : "+s"(bx_)); asm volatile("" : "+s"(zoff_));
        unsigned char* ws = a.ws + zoff_; float* outp = a.out + zoff_;
        Ctx c;
        c.in = a.in; c.ws = ws; c.X = outp; c.lds = (LAS unsigned char*)lds_raw;
        c.tid = tid_; c.lane = c.tid & 63; c.wave = __builtin_amdgcn_readfirstlane(c.tid >> 6);
        c.G = gridDim.x; c.gtid = bx_ * 512 + c.tid; c.NT = c.G * 512; c.gw = bx_ * 8 + c.wave; c.NGW = c.G * 8;
        bf16_t* XB = (bf16_t*)(ws + WS_XB);
        bf16_t* XBA = (bf16_t*)outp;
        float* ssq1 = (float*)(ws + WS_SSQ1); float* ssq2 = (float*)(ws + WS_SSQ2); float* ssq3 = (float*)(ws + WS_SSQ3);
        if (ph == 0) prologue(c);
        else if (ph == 1 + NSUB * DEPTH) final_phase(c);
        else {
            const int l = (ph - 1) / NSUB, s = (ph - 1) % NSUB;
            pg8::StaticOrder S;
            switch (s) {
#if !defined(ONLY) || ONLY == 0
            case 0: {
                pg8::Gemm g{XBA, (const bf16_t*)(ws + WS_WIN)}; S.init(M, WIN, c.G, bx_);
                pg8::EpiWin E{(bf16_t*)(ws + WS_RX), (bf16_t*)(ws + WS_CX), ssq1, (const LAS float*)(c.lds + SSQ_TAB_OFF)};
                pg8::gemm_phase<DM, DM, DM, 0, KREP_WIN>(c.lds, c.tid, g, S, E); } break;
#endif
#if !defined(ONLY) || ONLY == 1
            case 1: conv4_phase(c, l, bx_, LOCAL_SEAMS && bst[5] != 0u && c.G == 256); conv_late(c, l); break;
#endif
#if !defined(ONLY) || ONLY == 2
            case 2: {
                pg8::Gemm g{(const bf16_t*)(ws + WS_XC), (const bf16_t*)(ws + WS_WG)}; S.init(M, 2048, c.G, bx_);
                pg8::EpiGateScan E{(const bf16_t*)(ws + WS_XC), (bf16_t*)outp + (size_t)M * DM, (bf16_t*)(ws + WS_U), (float*)(ws + WS_PS), (float*)(ws + WS_HS), a.in[7] + l * DM, a.in[9] + l * DM, (const float*)(ws + WS_SP8) + l * DM};
                pg8::gemm_phase<256, DM, 256, 256>(c.lds, c.tid, g, S, E); } break;
#endif
#if !defined(ONLY) || ONLY == 5
            case 3: merge_phase(c, l, bx_); if (l + 1 < DEPTH) conv_early(c, l + 1); break;
#endif
#if !defined(ONLY) || ONLY == 6
            case 4: {
                { pg8::Gemm g{(const bf16_t*)(ws + WS_XC), (const bf16_t*)(ws + WS_WOUT)}; S.init(M, DM, c.G, bx_);
                  pg8::EpiRes E{XBA, XB, ssq2};
                  pg8::gemm_phase<DM, DM, DM, 0>(c.lds, c.tid, g, S, E); }
                { int tid2 = c.tid; asm volatile("" : "+v"(tid2));
                  pg8::Gemm g{(const bf16_t*)(ws + WS_PB), (const bf16_t*)(ws + WS_WPLE)}; S.init(M, DM, c.G, bx_);
                  pg8::EpiBf E{(bf16_t*)(ws + WS_U), DM};
                  pg8::gemm_phase<PLE, PLE, PLE, 0>(c.lds, tid2, g, S, E); } } break;
#endif
#if !defined(ONLY) || ONLY == 7
            case 5: {
                pg8::Gemm g{XB, (const bf16_t*)(ws + WS_WGU)}; S.init(M, 2 * DFF, c.G, bx_);
                pg8::EpiSwi E{(bf16_t*)(ws + WS_ACT), ssq2, (const LAS float*)(c.lds + SSQ_TAB_OFF)};
                pg8::gemm_phase<DM, DM, DM, 0>(c.lds, c.tid, g, S, E); } break;
#endif
#if !defined(ONLY) || ONLY == 8
            case 6: {
                pg8::Gemm g{(const bf16_t*)(ws + WS_ACT), (const bf16_t*)(ws + WS_WDN)}; S.init(M, DM, c.G, bx_);
                pg8::EpiRes E{XB, XB, ssq3};
                pg8::gemm_phase<DFF, DFF, DFF, 0>(c.lds, c.tid, g, S, E); } break;
#endif
#if !defined(ONLY) || ONLY == 9
            default: {
                pg8::Gemm g{XB, (const bf16_t*)(ws + WS_WPG)}; S.init(M, DM, c.G, bx_);
                pg8::EpiPle E{XB, (l == DEPTH - 1) ? (bf16_t*)(ws + WS_XC) : XBA, (const bf16_t*)(ws + WS_U), ssq3, ssq1, (const LAS float*)(c.lds + SSQ_TAB_OFF)};
                pg8::gemm_phase<DM, DM, DM, 0>(c.lds, c.tid, g, S, E); } break;
#endif
            }
        }
        if (ph + 1 < a.ph_hi) {
            const int s_ = (ph >= 1 && ph <= NSUB * DEPTH) ? (ph - 1) % NSUB : -1;
            if (a.ph_hi < 0) grid.sync();
            else xcd_barrier(xbar, LOCAL_SEAMS && (s_ == 4 || s_ == 5 || s_ == 6 || (s_ == 1 && gridDim.x == 256u)) && bst[5] != 0u,
                             LOCAL_SEAMS && s_ == 7 && ph < NSUB * DEPTH && bst[5] != 0u); }
        for (int xs = 0; xs < EXTRA_SYNCS; ++xs) xcd_barrier(xbar);
        if (DUPMASK != 0 && ph >= 1 && ph <= NSUB * DEPTH && ((DUPMASK >> ((ph - 1) % NSUB)) & 1) && !dup_done) { dup_done = true; --ph; } else dup_done = false;
    }
}

extern "C" void kernel_launch(void* const* d_in, const int* in_sizes, int n_in, void* d_out, int out_size, void* d_ws, size_t ws_size, hipStream_t stream) {
    static int grid = 0;
    if (grid == 0) {
        if (n_in != 20 || out_size != M * DM || ws_size < WS_END) { fprintf(stderr, "kernel_launch: unexpected sizes n_in %d out %d ws %zu\n", n_in, out_size, ws_size); grid = -1; return; }
        int dev = 0, cus = 0, per_cu = 0;
        hipGetDevice(&dev); hipDeviceGetAttribute(&cus, hipDeviceAttributeMultiprocessorCount, dev);
        if (hipFuncSetAttribute((const void*)fwd_mega, hipFuncAttributeMaxDynamicSharedMemorySize, LDS_BYTES) != hipSuccess) { fprintf(stderr, "kernel_launch: hipFuncSetAttribute failed\n"); grid = -1; return; }
        if (hipOccupancyMaxActiveBlocksPerMultiprocessor(&per_cu, (const void*)fwd_mega, 512, LDS_BYTES) != hipSuccess || per_cu < 1) { fprintf(stderr, "kernel_launch: occupancy query gives %d\n", per_cu); per_cu = 1; }
        (void)hipGetLastError();
        grid = cus * 1;
    }
    if (grid < 0) return;
    if (hipMemsetAsync((char*)d_ws + WS_BAR, 0, BAR_BYTES, stream) != hipSuccess) { fprintf(stderr, "kernel_launch: memset failed\n"); return; }
    Args a{};
    for (int i = 0; i < 20; ++i) a.in[i] = (const float*)d_in[i];
    a.out = (float*)d_out; a.ws = (unsigned char*)d_ws; a.ph_lo = 0; a.ph_hi = 2 + NSUB * DEPTH;
    void* args[] = {&a};
    hipError_t e = hipLaunchCooperativeKernel((const void*)fwd_mega, dim3(grid), dim3(512), args, LDS_BYTES, stream);
    if (e != hipSuccess) fprintf(stderr, "cooperative launch failed: %s (grid %d)\n", hipGetErrorString(e), grid);
}
```

```cpp
#include <hip/hip_runtime.h>
#include <hip/hip_cooperative_groups.h>
#include <cstdio>
#include <cstdint>
namespace cg = cooperative_groups;

#define LAS __attribute__((address_space(3)))
typedef unsigned short bf16_t;
typedef short bf16x8 __attribute__((ext_vector_type(8)));
typedef float f32x4 __attribute__((ext_vector_type(4)));
typedef float f32x2 __attribute__((ext_vector_type(2)));
typedef unsigned u32x4 __attribute__((ext_vector_type(4)));
typedef unsigned u32x2 __attribute__((ext_vector_type(2)));

constexpr int DM = 1024, BATCH = 4, SEQ = 8192, DEPTH = 4, M = BATCH * SEQ;
constexpr int DFF = 2816, WIN = 7168, PLE = 256;
constexpr int LCH = 64, NCHUNK = M / LCH;
constexpr float EPS = 1e-6f;

constexpr size_t MiB = 1u << 20;
constexpr size_t WS_SSQ1 = 0 * MiB, WS_SSQ2 = 2 * MiB, WS_SSQ3 = 4 * MiB, WS_PS = 6 * MiB, WS_HS = 8 * MiB, WS_CARRY = 10 * MiB, WS_SP8 = 12 * MiB;
constexpr size_t WS_BAR = 13 * MiB, BAR_BYTES = 16384;
constexpr size_t WS_WIN = 16 * MiB;
constexpr size_t WS_WG = 30 * MiB;
constexpr size_t WS_WOUT = 32 * MiB;
constexpr size_t WS_WGU = 34 * MiB;
constexpr size_t WS_WDN = 45 * MiB;
constexpr size_t WS_WPG = 51 * MiB;
constexpr size_t WS_WPLE = 53 * MiB;
constexpr size_t WS_PB = 56 * MiB;
constexpr size_t WS_XB = 72 * MiB;
constexpr size_t WS_RX = 136 * MiB;
constexpr size_t WS_CX = 200 * MiB;
constexpr size_t WS_GY = 264 * MiB;
constexpr size_t WS_GB = 328 * MiB;
constexpr size_t WS_XC = 392 * MiB;
constexpr size_t WS_U = 456 * MiB;
constexpr size_t WS_ACT = 136 * MiB;
constexpr size_t WS_END = 520 * MiB;
static_assert(WS_GY == WS_CX + 64 * MiB && WS_GB == WS_GY + 64 * MiB, "CX | GY | GB consecutive");

constexpr int NSUB = 8;
constexpr int RING_BYTES = 131072;
constexpr int SSQ_TAB_OFF = RING_BYTES + 1024;
constexpr int LDS_BYTES = SSQ_TAB_OFF + 16384 + 1024;

__device__ __forceinline__ unsigned cvt_pk_bf16(float lo, float hi) { unsigned r; asm("v_cvt_pk_bf16_f32 %0, %1, %2" : "=v"(r) : "v"(lo), "v"(hi)); return r; }
__device__ __forceinline__ u32x4 pack8(const float (&f)[8]) { u32x4 w; w.x = cvt_pk_bf16(f[0], f[1]); w.y = cvt_pk_bf16(f[2], f[3]); w.z = cvt_pk_bf16(f[4], f[5]); w.w = cvt_pk_bf16(f[6], f[7]); return w; }
__device__ __forceinline__ void unpack8(const u32x4 w, float (&f)[8]) {
    f[0] = __uint_as_float(w.x << 16); f[1] = __uint_as_float(w.x & 0xffff0000u); f[2] = __uint_as_float(w.y << 16); f[3] = __uint_as_float(w.y & 0xffff0000u);
    f[4] = __uint_as_float(w.z << 16); f[5] = __uint_as_float(w.z & 0xffff0000u); f[6] = __uint_as_float(w.w << 16); f[7] = __uint_as_float(w.w & 0xffff0000u); }
__device__ __forceinline__ void unpack4(const u32x2 w, float (&f)[4]) {
    f[0] = __uint_as_float(w.x << 16); f[1] = __uint_as_float(w.x & 0xffff0000u); f[2] = __uint_as_float(w.y << 16); f[3] = __uint_as_float(w.y & 0xffff0000u); }
__device__ __forceinline__ float sum_fq(float s) {
    const u32x2 a = __builtin_amdgcn_permlane16_swap(__float_as_uint(s), __float_as_uint(s), false, false);
    const float t = __uint_as_float(a.x) + __uint_as_float(a.y);
    const u32x2 b = __builtin_amdgcn_permlane32_swap(__float_as_uint(t), __float_as_uint(t), false, false);
    return __uint_as_float(b.x) + __uint_as_float(b.y);
}
__device__ __forceinline__ float sigm(float v) { return __builtin_amdgcn_rcpf(1.f + __expf(-v)); }
__device__ __forceinline__ float gelu_tanh(float v) { return v * sigm(1.5957691216057308f * (v + 0.044715f * v * v * v)); }
__device__ __forceinline__ float row_rstd(const float* ssq, int row) {
    const f32x4* p = (const f32x4*)(ssq + (size_t)row * 16);
    const f32x4 a = p[0], b = p[1], c = p[2], d = p[3];
    const float s = (((a.x + a.y) + (a.z + a.w)) + ((b.x + b.y) + (b.z + b.w))) + (((c.x + c.y) + (c.z + c.w)) + ((d.x + d.y) + (d.z + d.w)));
    return rsqrtf(s * (1.0f / DM) + EPS);
}
__device__ __forceinline__ float row_rstd_q(const float* ssq, int row, int fq) {
    const f32x4 a = *(const f32x4*)(ssq + (size_t)row * 16 + fq * 4);
    float s = (a.x + a.y) + (a.z + a.w); s = sum_fq(s);
    return rsqrtf(s * (1.0f / DM) + EPS);
}
__device__ __forceinline__ f32x4 exp2n4(f32x4 x) {
    const f32x4 a = x * (-1.4426950408889634f); f32x4 e; e.x = __builtin_amdgcn_exp2f(a.x); e.y = __builtin_amdgcn_exp2f(a.y); e.z = __builtin_amdgcn_exp2f(a.z); e.w = __builtin_amdgcn_exp2f(a.w); return e; }
__device__ __forceinline__ f32x4 rcp4(f32x4 d) { f32x4 r; r.x = __builtin_amdgcn_rcpf(d.x); r.y = __builtin_amdgcn_rcpf(d.y); r.z = __builtin_amdgcn_rcpf(d.z); r.w = __builtin_amdgcn_rcpf(d.w); return r; }
__device__ __forceinline__ f32x4 sigm4(f32x4 x) { return rcp4(exp2n4(x) + 1.0f); }
__device__ __forceinline__ u32x2 pack4(f32x4 v) { u32x2 w; w.x = cvt_pk_bf16(v.x, v.y); w.y = cvt_pk_bf16(v.z, v.w); return w; }
__device__ __forceinline__ f32x4 unpack4v(const u32x2 w) { return (f32x4){__uint_as_float(w.x << 16), __uint_as_float(w.x & 0xffff0000u), __uint_as_float(w.y << 16), __uint_as_float(w.y & 0xffff0000u)}; }
__device__ __forceinline__ float row_rstd_lds(const LAS float* tab, int rl, int fq) {
    const f32x4 a = *(const LAS f32x4*)(tab + rl * 16 + fq * 4);
    float s = (a.x + a.y) + (a.z + a.w); s = sum_fq(s);
    return rsqrtf(s * (1.0f / DM) + EPS);
}
#define EPI_FENCE() asm volatile("" ::: "memory")
#define LDS_WAIT() asm volatile("s_waitcnt lgkmcnt(0)" ::: "memory")

namespace pg8 {
constexpr int BM = 256, BK = 64, HALF = 128, HTB = HALF * BK * 2, NXCD = 8, WGM = 8;
__host__ __device__ __forceinline__ int lds_byte(int r, int c) { const int st = (r >> 4) * 2 + (c >> 5), rr = r & 15, cc = c & 31, ob = rr * 64 + cc * 2; return st * 1024 + (ob ^ (((ob >> 9) & 1) << 5)); }
__host__ __device__ __forceinline__ void stage_rc(int b, int& R, int& C) { const int st = b / 1024, sb = b % 1024, swz = sb ^ (((sb >> 9) & 1) << 5); R = (st >> 1) * 16 + swz / 64; C = (st & 1) * 32 + (swz % 64) / 2; }
__host__ __device__ __forceinline__ int perm32(int rho) { const int n = rho >> 4, i = rho & 15; return 8 * (i >> 2) + 4 * n + (i & 3); }

struct Unit { int pm, pn; };
struct Gemm { const bf16_t* A; const bf16_t* Bt; };

struct StaticOrder {
    int nM, nN, nwg, G, c;
    __device__ void init(int M_, int N_, int G_, int c_) { nM = M_ / BM; nN = N_ / BM; nwg = nM * nN; G = G_; c = c_; }
    __device__ bool next(int i, Unit& u) const {
        const long L = (long)i * G + c; if (L >= nwg) return false;
        int wgid = (int)L; { const int q = nwg / NXCD, r = nwg % NXCD, xcd = wgid % NXCD, off = wgid / NXCD; wgid = (xcd < r ? xcd * (q + 1) : r * (q + 1) + (xcd - r) * q) + off; }
        const int nig = WGM * nN, gid = wgid / nig, fm = gid * WGM, gsz = (nM - fm) < WGM ? (nM - fm) : WGM;
        u.pm = fm + ((wgid % nig) % gsz); u.pn = (wgid % nig) / gsz; return true;
    }
};

typedef f32x4 Acc[2][2][4][2];

struct EpiWin {
    static constexpr bool PREF = true;
    bf16_t* RX; bf16_t* CX; const float* ssq; const LAS float* tab;
    __device__ __forceinline__ void operator()(const Acc& acc, const Unit& u, int wr, int wc, int fr, int fq) const {
        const int row0 = u.pm * BM + wr * 64 + fr;
        float rsv[2][4];
#pragma unroll
        for (int ai = 0; ai < 2; ++ai)
#pragma unroll
            for (int m = 0; m < 4; ++m) rsv[ai][m] = row_rstd_lds(tab, wr * 64 + fr + ai * HALF + m * 16, fq);
        EPI_FENCE();
        if (u.pn < 4) {
#pragma unroll
            for (int ai = 0; ai < 2; ++ai)
#pragma unroll
                for (int m = 0; m < 4; ++m) { const int row = row0 + ai * HALF + m * 16; const float rs = rsv[ai][m];
                    bf16_t* rp = RX + (size_t)row * DM + u.pn * BM + wc * 32 + 8 * fq;
#pragma unroll
                    for (int bj = 0; bj < 2; ++bj) { const u32x2 p0 = pack4(acc[ai][bj][m][0] * rs), p1 = pack4(acc[ai][bj][m][1] * rs);
                        *(u32x4*)(rp + bj * HALF) = (u32x4){p0.x, p0.y, p1.x, p1.y}; } EPI_FENCE(); }
        } else {
            const int q = (u.pn - 4) >> 3, j = (u.pn - 4) & 7;
            bf16_t* dst = CX + (size_t)q * (size_t)(32u << 20) + j * 128 + wc * 32 + 8 * fq;
#pragma unroll
            for (int ai = 0; ai < 2; ++ai)
#pragma unroll
                for (int m = 0; m < 4; ++m) { const int row = row0 + ai * HALF + m * 16; const float rs = rsv[ai][m];
                    u32x4 w;
#pragma unroll
                    for (int n = 0; n < 2; ++n) { const f32x4 v0 = acc[ai][0][m][n] * rs, v1 = acc[ai][1][m][n] * rs; f32x4 o;
                        if (q == 0) o = v0 * v1;
                        else if (q == 1) { const f32x4 t = (v0 * v0 * 0.044715f + 1.0f) * v0 * 1.5957691216057308f;
                            o = v0 * rcp4((exp2n4(t) + 1.0f) * (exp2n4(v1) + 1.0f)); }
                        else o = v0 * sigm4(v1);
                        const u32x2 p = pack4(o); if (n == 0) { w.x = p.x; w.y = p.y; } else { w.z = p.x; w.w = p.y; } }
                    *(u32x4*)(dst + (size_t)row * DM) = w; EPI_FENCE(); }
        }
    }
};
struct EpiGate {
    static constexpr bool PREF = false;
    bf16_t* PR; bf16_t* PI; const float* br; const float* bi;
    __device__ __forceinline__ void operator()(const Acc& acc, const Unit& u, int wr, int wc, int fr, int fq) const {
        const int row0 = u.pm * BM + wr * 64 + fr;
        const int c0 = (u.pn >> 1) * 256 + (u.pn & 1) * 128 + wc * 32 + 8 * fq;
        const f32x4 br0 = *(const f32x4*)(br + c0), br1 = *(const f32x4*)(br + c0 + 4), bi0 = *(const f32x4*)(bi + c0), bi1 = *(const f32x4*)(bi + c0 + 4);
#pragma unroll
        for (int ai = 0; ai < 2; ++ai)
#pragma unroll
            for (int m = 0; m < 4; ++m) { const int row = row0 + ai * HALF + m * 16; const unsigned off = (unsigned)row * DM + c0;
                const u32x2 r0 = pack4(acc[ai][0][m][0] + br0), r1 = pack4(acc[ai][0][m][1] + br1), i0 = pack4(acc[ai][1][m][0] + bi0), i1 = pack4(acc[ai][1][m][1] + bi1);
                *(u32x4*)(PR + off) = (u32x4){r0.x, r0.y, r1.x, r1.y}; *(u32x4*)(PI + off) = (u32x4){i0.x, i0.y, i1.x, i1.y}; EPI_FENCE(); }
    }
};
template <int N> __device__ __forceinline__ float dpp_row_shr(float v, float ident) {
    return __int_as_float(__builtin_amdgcn_update_dpp(__float_as_int(ident), __float_as_int(v), 0x110 | N, 0xf, 0xf, false)); }
template <int N> __device__ __forceinline__ void scan_step(f32x4& a, f32x4& uu) {
#pragma unroll
    for (int e = 0; e < 4; ++e) { const float ap = dpp_row_shr<N>(a[e], 1.0f), up = dpp_row_shr<N>(uu[e], 0.0f); uu[e] = a[e] * up + uu[e]; a[e] = a[e] * ap; } }
__device__ __forceinline__ void scan16(f32x4& a, f32x4& uu) {
    float a0 = a.x, a1 = a.y, a2 = a.z, a3 = a.w, u0 = uu.x, u1 = uu.y, u2 = uu.z, u3 = uu.w;
#define SC_STEP(N) \
        "v_fmac_f32_dpp %4, %4, %0 row_shr:" #N " row_mask:0xf bank_mask:0xf\n\t" "v_fmac_f32_dpp %5, %5, %1 row_shr:" #N " row_mask:0xf bank_mask:0xf\n\t" \
        "v_fmac_f32_dpp %6, %6, %2 row_shr:" #N " row_mask:0xf bank_mask:0xf\n\t" "v_fmac_f32_dpp %7, %7, %3 row_shr:" #N " row_mask:0xf bank_mask:0xf\n\t" \
        "v_mul_f32_dpp %0, %0, %0 row_shr:" #N " row_mask:0xf bank_mask:0xf\n\t" "v_mul_f32_dpp %1, %1, %1 row_shr:" #N " row_mask:0xf bank_mask:0xf\n\t" \
        "v_mul_f32_dpp %2, %2, %2 row_shr:" #N " row_mask:0xf bank_mask:0xf\n\t" "v_mul_f32_dpp %3, %3, %3 row_shr:" #N " row_mask:0xf bank_mask:0xf\n\t"
    asm volatile("s_nop 1\n\t" SC_STEP(1) SC_STEP(2) SC_STEP(4) SC_STEP(8) : "+v"(a0), "+v"(a1), "+v"(a2), "+v"(a3), "+v"(u0), "+v"(u1), "+v"(u2), "+v"(u3));
#undef SC_STEP
    a = (f32x4){a0, a1, a2, a3}; uu = (f32x4){u0, u1, u2, u3};
}
struct EpiGateScan {
    static constexpr bool PREF = false;
    const bf16_t* XC; bf16_t* CP; bf16_t* HL; float* PS; float* HS; const float* br; const float* bi; const float* sp8;
    __device__ __forceinline__ void operator()(const Acc& acc, const Unit& u, int wr, int wc, int fr, int fq) const {
        const int row0 = u.pm * BM + wr * 64 + fr;
        const int c0 = (u.pn >> 1) * 256 + (u.pn & 1) * 128 + wc * 32 + 8 * fq;
        const int baddr = ((fq * 16) | 15) * 4;
        f32x4 b_r[2], b_i[2], sp[2];
#pragma unroll
        for (int nh = 0; nh < 2; ++nh) { b_r[nh] = *(const f32x4*)(br + c0 + 4 * nh); b_i[nh] = *(const f32x4*)(bi + c0 + 4 * nh); sp[nh] = *(const f32x4*)(sp8 + c0 + 4 * nh); }
#pragma unroll
        for (int ai = 0; ai < 2; ++ai) {
            u32x4 xw[4];
#pragma unroll
            for (int m = 0; m < 4; ++m) xw[m] = *(const u32x4*)(XC + (unsigned)(row0 + ai * HALF + m * 16) * DM + c0);
            EPI_FENCE();
            f32x4 Ac[2], Hc[2], cp[2], hl[2];
#pragma unroll
            for (int nh = 0; nh < 2; ++nh) { Ac[nh] = (f32x4){1.f, 1.f, 1.f, 1.f}; Hc[nh] = (f32x4){0.f, 0.f, 0.f, 0.f}; }
#pragma unroll
            for (int m = 0; m < 4; ++m) { const unsigned off = (unsigned)(row0 + ai * HALF + m * 16) * DM + c0;
#pragma unroll
                for (int nh = 0; nh < 2; ++nh) {
                    const f32x4 xc = nh == 0 ? unpack4v((u32x2){xw[m].x, xw[m].y}) : unpack4v((u32x2){xw[m].z, xw[m].w});
                    const f32x4 r = sigm4(acc[ai][0][m][nh] + b_r[nh]), ig = sigm4(acc[ai][1][m][nh] + b_i[nh]);
                    const f32x4 lg = -(r * sp[nh]);
                    f32x4 a = exp2n4(-lg);
                    const f32x4 om = 1.0f - a * a;
                    f32x4 s; s.x = __builtin_amdgcn_sqrtf(om.x); s.y = __builtin_amdgcn_sqrtf(om.y); s.z = __builtin_amdgcn_sqrtf(om.z); s.w = __builtin_amdgcn_sqrtf(om.w);
                    f32x4 uu = s * ig * xc;
                    scan16(a, uu);
                    cp[nh] = Ac[nh] * a; hl[nh] = uu + a * Hc[nh];
                    if (m < 3) {
#pragma unroll
                        for (int e = 0; e < 4; ++e) { Ac[nh][e] = __int_as_float(__builtin_amdgcn_update_dpp(0, __float_as_int(cp[nh][e]), 0x15F, 0xf, 0xf, false)); Hc[nh][e] = __int_as_float(__builtin_amdgcn_update_dpp(0, __float_as_int(hl[nh][e]), 0x15F, 0xf, 0xf, false)); } }
                }
                const u32x2 q0 = pack4(cp[0]), q1 = pack4(cp[1]), h0 = pack4(hl[0]), h1 = pack4(hl[1]);
                *(u32x4*)(CP + off) = (u32x4){q0.x, q0.y, q1.x, q1.y}; *(u32x4*)(HL + off) = (u32x4){h0.x, h0.y, h1.x, h1.y}; }
            if (fr == 15) { const size_t t = (size_t)(u.pm * 4 + ai * 2 + wr) * DM + c0;
                *(f32x4*)(PS + t) = cp[0]; *(f32x4*)(PS + t + 4) = cp[1]; *(f32x4*)(HS + t) = hl[0]; *(f32x4*)(HS + t + 4) = hl[1]; }
            EPI_FENCE();
        }
    }
};
struct EpiRes {
    static constexpr bool PREF = false;
    const bf16_t* xin; bf16_t* xout; float* ssq;
    __device__ __forceinline__ void operator()(const Acc& acc, const Unit& u, int wr, int wc, int fr, int fq) const {
        const int row0 = u.pm * BM + wr * 64 + fr; const int col0 = u.pn * BM + wc * 32 + 8 * fq;
#pragma unroll
        for (int ai = 0; ai < 2; ++ai) {
            u32x4 xw[4][2];
#pragma unroll
            for (int m = 0; m < 4; ++m)
#pragma unroll
                for (int bj = 0; bj < 2; ++bj) xw[m][bj] = *(const u32x4*)(xin + (unsigned)(row0 + ai * HALF + m * 16) * DM + col0 + bj * HALF);
            EPI_FENCE();
#pragma unroll
            for (int m = 0; m < 4; ++m) { const int row = row0 + ai * HALF + m * 16; float ss = 0.f;
#pragma unroll
                for (int bj = 0; bj < 2; ++bj) { const unsigned off = (unsigned)row * DM + col0 + bj * HALF;
                    const f32x4 v0 = unpack4v((u32x2){xw[m][bj].x, xw[m][bj].y}) + acc[ai][bj][m][0], v1 = unpack4v((u32x2){xw[m][bj].z, xw[m][bj].w}) + acc[ai][bj][m][1];
                    const f32x4 q = v0 * v0 + v1 * v1; ss += (q.x + q.y) + (q.z + q.w);
                    const u32x2 p0 = pack4(v0), p1 = pack4(v1); *(u32x4*)(xout + off) = (u32x4){p0.x, p0.y, p1.x, p1.y}; }
                ss = sum_fq(ss);
                if (fq == 0) ssq[(size_t)row * 16 + u.pn * 4 + wc] = ss; }
            EPI_FENCE();
        }
    }
};
struct EpiPle {
    static constexpr bool PREF = true;
    const bf16_t* xin; bf16_t* xout; const bf16_t* E; const float* ssq; float* ssq_out; const LAS float* tab;
    __device__ __forceinline__ void operator()(const Acc& acc, const Unit& u, int wr, int wc, int fr, int fq) const {
        const int row0 = u.pm * BM + wr * 64 + fr; const int col0 = u.pn * BM + wc * 32 + 8 * fq;
        float rsv[2][4];
#pragma unroll
        for (int ai = 0; ai < 2; ++ai)
#pragma unroll
            for (int m = 0; m < 4; ++m) rsv[ai][m] = row_rstd_lds(tab, wr * 64 + fr + ai * HALF + m * 16, fq);
        EPI_FENCE();
#pragma unroll
        for (int ai = 0; ai < 2; ++ai)
#pragma unroll
            for (int mh = 0; mh < 4; mh += 2) {
                u32x4 xw[2][2], ew[2][2];
#pragma unroll
                for (int m = 0; m < 2; ++m)
#pragma unroll
                    for (int bj = 0; bj < 2; ++bj) { const unsigned off = (unsigned)(row0 + ai * HALF + (mh + m) * 16) * DM + col0 + bj * HALF; xw[m][bj] = *(const u32x4*)(xin + off); ew[m][bj] = *(const u32x4*)(E + off); }
                EPI_FENCE();
#pragma unroll
                for (int m = 0; m < 2; ++m) { const int row = row0 + ai * HALF + (mh + m) * 16; const float rs = rsv[ai][mh + m]; float ss = 0.f;
#pragma unroll
                    for (int bj = 0; bj < 2; ++bj) { const unsigned off = (unsigned)row * DM + col0 + bj * HALF;
                        const f32x4 v0 = unpack4v((u32x2){xw[m][bj].x, xw[m][bj].y}) + sigm4(acc[ai][bj][mh + m][0] * rs) * unpack4v((u32x2){ew[m][bj].x, ew[m][bj].y});
                        const f32x4 v1 = unpack4v((u32x2){xw[m][bj].z, xw[m][bj].w}) + sigm4(acc[ai][bj][mh + m][1] * rs) * unpack4v((u32x2){ew[m][bj].z, ew[m][bj].w});
                        const f32x4 q = v0 * v0 + v1 * v1; ss += (q.x + q.y) + (q.z + q.w);
                        const u32x2 p0 = pack4(v0), p1 = pack4(v1); *(u32x4*)(xout + off) = (u32x4){p0.x, p0.y, p1.x, p1.y}; }
                    ss = sum_fq(ss);
                    if (fq == 0) ssq_out[(size_t)row * 16 + u.pn * 4 + wc] = ss; }
                EPI_FENCE();
            }
    }
};
struct EpiSwi {
    static constexpr bool PREF = true;
    bf16_t* ACT; const float* ssq; const LAS float* tab;
    __device__ __forceinline__ void operator()(const Acc& acc, const Unit& u, int wr, int wc, int fr, int fq) const {
        const int row0 = u.pm * BM + wr * 64 + fr; const int col0 = u.pn * 128 + wc * 32 + 8 * fq;
        float rsv[2][4];
#pragma unroll
        for (int ai = 0; ai < 2; ++ai)
#pragma unroll
            for (int m = 0; m < 4; ++m) rsv[ai][m] = row_rstd_lds(tab, wr * 64 + fr + ai * HALF + m * 16, fq);
        EPI_FENCE();
#pragma unroll
        for (int ai = 0; ai < 2; ++ai)
#pragma unroll
            for (int m = 0; m < 4; ++m) { const int row = row0 + ai * HALF + m * 16; const float rs = rsv[ai][m];
                const f32x4 g0 = acc[ai][0][m][0] * rs, g1 = acc[ai][0][m][1] * rs;
                const u32x2 p0 = pack4(g0 * sigm4(g0) * (acc[ai][1][m][0] * rs)), p1 = pack4(g1 * sigm4(g1) * (acc[ai][1][m][1] * rs));
                *(u32x4*)(ACT + (size_t)row * DFF + col0) = (u32x4){p0.x, p0.y, p1.x, p1.y}; EPI_FENCE(); }
    }
};
struct EpiBf {
    static constexpr bool PREF = false;
    bf16_t* O; int ldc;
    __device__ __forceinline__ void operator()(const Acc& acc, const Unit& u, int wr, int wc, int fr, int fq) const {
        const int row0 = u.pm * BM + wr * 64 + fr; const int col0 = u.pn * BM + wc * 32 + 8 * fq;
#pragma unroll
        for (int ai = 0; ai < 2; ++ai)
#pragma unroll
            for (int m = 0; m < 4; ++m) { const int row = row0 + ai * HALF + m * 16;
#pragma unroll
                for (int bj = 0; bj < 2; ++bj) { float v[8];
#pragma unroll
                    for (int e = 0; e < 8; ++e) v[e] = acc[ai][bj][m][e >> 2][e & 3];
                    *(u32x4*)(O + (size_t)row * ldc + col0 + bj * HALF) = pack8(v); } EPI_FENCE(); }
    }
};

template <int K, int LDA, int LDB, int ACS, int KREP = 1, class Epi>
__device__ __forceinline__ void gemm_phase(LAS unsigned char* lds, const int tid, const Gemm g, const StaticOrder& S, const Epi& E) {
    const int wid = __builtin_amdgcn_readfirstlane(tid >> 6), lane = tid & 63, wr = wid >> 2, wc = wid & 3, fr = lane & 15, fq = lane >> 4;
    constexpr int nt = K / BK;
    unsigned voffA[2], voffB[2];
#pragma unroll
    for (int i = 0; i < 2; ++i) { int R, C; stage_rc(tid * 16 + i * 8192, R, C); const int Rb = (R & ~31) + perm32(R & 31);
        voffA[i] = (unsigned)(R * LDA + C) * 2u; voffB[i] = (unsigned)(Rb * LDB + C) * 2u; }
    constexpr size_t kstep = (size_t)(BK * 2);
    constexpr size_t hstepA = (size_t)HALF * LDA * 2, hstepB = (size_t)HALF * LDB * 2;
    constexpr size_t tstepA = 2 * hstepA, tstepB = 2 * hstepB;
    const unsigned ldsw = (unsigned)wid * 1024u;
    const int aoff = lds_byte(wr * 64 + fr, fq * 8), boff = lds_byte(wc * 32 + fr, fq * 8);
#define PG8_SA(b, h) (((b) * 2 + (h)) * HTB)
#define PG8_SB(b, h) ((4 + (b) * 2 + (h)) * HTB)
#define PG8_STAGE(bufoff, gbase, voff) do { _Pragma("unroll") for (int _i = 0; _i < 2; ++_i) \
        __builtin_amdgcn_global_load_lds((const unsigned*)((const char*)(gbase) + (voff)[_i]), (LAS unsigned*)(lds + (bufoff) + ldsw + _i * 8192), 16, 0, 0); } while (0)
#define PG8_LDA(dst, b, h) do { _Pragma("unroll") for (int m = 0; m < 4; ++m) _Pragma("unroll") for (int k = 0; k < 2; ++k) dst[m][k] = *(const LAS bf16x8*)(lds + PG8_SA(b, h) + aoff + m * 2048 + k * 1024); } while (0)
#define PG8_LDB(dst, b, h) do { _Pragma("unroll") for (int n = 0; n < 2; ++n) _Pragma("unroll") for (int k = 0; k < 2; ++k) dst[n][k] = *(const LAS bf16x8*)(lds + PG8_SB(b, h) + boff + n * 2048 + k * 1024); } while (0)
#define PG8_MMA(ai, bj, At, Bt) do { __builtin_amdgcn_s_setprio(1); _Pragma("unroll") for (int m = 0; m < 4; ++m) _Pragma("unroll") for (int n = 0; n < 2; ++n) _Pragma("unroll") for (int k = 0; k < 2; ++k) \
        acc[ai][bj][m][n] = __builtin_amdgcn_mfma_f32_16x16x32_bf16(Bt[n][k], At[m][k], acc[ai][bj][m][n], 0, 0, 0); __builtin_amdgcn_s_setprio(0); } while (0)
#define PG8_WAIT_V(n) asm volatile("s_waitcnt vmcnt(" #n ")" ::: "memory")
#define PG8_WAIT_L(n) asm volatile("s_waitcnt lgkmcnt(" #n ")" ::: "memory")
#define PG8_BAR __builtin_amdgcn_s_barrier()
#define PG8_SCHED __builtin_amdgcn_sched_barrier(0)
    Unit cur, nxt; int ui = 0;
    if (!S.next(0, cur)) return;
    Acc acc;
#pragma unroll
    for (int a = 0; a < 2; ++a)
#pragma unroll
        for (int b = 0; b < 2; ++b)
#pragma unroll
            for (int m = 0; m < 4; ++m)
#pragma unroll
                for (int n = 0; n < 2; ++n) acc[a][b][m][n] = (f32x4){0.f, 0.f, 0.f, 0.f};
    bf16x8 At[4][2], B0[2][2], B1[2][2];
    const char* cA = (const char*)g.A + (size_t)cur.pm * tstepA + (size_t)((cur.pn >> 1) * ACS) * 2; const char* cB = (const char*)g.Bt + (size_t)cur.pn * tstepB;
    PG8_STAGE(PG8_SB(0, 0), cB, voffB); PG8_STAGE(PG8_SB(0, 1), cB + hstepB, voffB); PG8_STAGE(PG8_SA(0, 0), cA, voffA); PG8_STAGE(PG8_SA(0, 1), cA + hstepA, voffA);
    if (wr == 1) PG8_BAR;
    PG8_WAIT_V(2); PG8_BAR;
    PG8_STAGE(PG8_SB(1, 0), cB + kstep, voffB); PG8_STAGE(PG8_SA(1, 0), cA + kstep, voffA); PG8_STAGE(PG8_SB(1, 1), cB + hstepB + kstep, voffB);
    PG8_WAIT_V(6); PG8_BAR;
    for (;;) {
        const bool has_next = S.next(ui + 1, nxt);
        const char* nA = has_next ? (const char*)g.A + (size_t)nxt.pm * tstepA + (size_t)((nxt.pn >> 1) * ACS) * 2 : cA; const char* nB = has_next ? (const char*)g.Bt + (size_t)nxt.pn * tstepB : cB;
#pragma unroll 1
        for (int tt = 0; tt < nt * KREP; tt += 2) {
            const int t = (KREP == 1) ? tt : tt % nt;
            const bool last = (t == nt - 2), lastrep = (KREP == 1) || (tt == nt * KREP - 2);
            const char* a1 = cA + (size_t)(t + 1) * kstep;
            const char* a2 = last ? (lastrep ? nA : cA) : cA + (size_t)(t + 2) * kstep; const char* b2 = last ? (lastrep ? nB : cB) : cB + (size_t)(t + 2) * kstep;
            const char* a3 = a2 + kstep; const char* b3 = b2 + kstep;
            PG8_LDB(B0, 0, 0); PG8_LDB(B1, 0, 1); PG8_SCHED; PG8_LDA(At, 0, 0); PG8_STAGE(PG8_SA(1, 1), a1 + hstepA, voffA);
            PG8_WAIT_V(8); PG8_WAIT_L(0); PG8_BAR; PG8_MMA(0, 0, At, B0); PG8_MMA(0, 1, At, B1); PG8_BAR; PG8_SCHED;
            if constexpr (Epi::PREF) { if (tt == 0) {
#pragma unroll
                for (int q_ = 0; q_ < 2; ++q_) { const int p_ = 2 * wc + q_, rl_ = (p_ >> 2) * HALF + wr * 64 + (p_ & 3) * 16;
                    __builtin_amdgcn_global_load_lds((const unsigned*)(E.ssq + ((size_t)cur.pm * BM + rl_) * 16 + lane * 4), (LAS unsigned*)(lds + SSQ_TAB_OFF + rl_ * 64), 16, 0, 0); } }
                PG8_SCHED; }
            PG8_LDA(At, 0, 1); PG8_STAGE(PG8_SB(0, 0), b2, voffB); PG8_STAGE(PG8_SB(0, 1), b2 + hstepB, voffB); PG8_STAGE(PG8_SA(0, 0), a2, voffA);
            PG8_WAIT_V(8); PG8_WAIT_L(0); PG8_BAR; PG8_MMA(1, 0, At, B0); PG8_MMA(1, 1, At, B1); PG8_BAR; PG8_SCHED;
            PG8_LDB(B0, 1, 0); PG8_LDB(B1, 1, 1); PG8_SCHED; PG8_LDA(At, 1, 0); PG8_STAGE(PG8_SA(0, 1), a2 + hstepA, voffA);
            PG8_WAIT_V(8); PG8_WAIT_L(0); PG8_BAR; PG8_MMA(0, 0, At, B0); PG8_MMA(0, 1, At, B1); PG8_BAR; PG8_SCHED;
            PG8_LDA(At, 1, 1); PG8_STAGE(PG8_SB(1, 0), b3, voffB); PG8_STAGE(PG8_SB(1, 1), b3 + hstepB, voffB); PG8_STAGE(PG8_SA(1, 0), a3, voffA);
            PG8_WAIT_V(8); PG8_WAIT_L(0); PG8_BAR; PG8_MMA(1, 0, At, B0); PG8_MMA(1, 1, At, B1); PG8_BAR; PG8_SCHED;
        }
        if (wr == 0) PG8_BAR;
        if constexpr (KREP != 1) {
#pragma unroll
            for (int a = 0; a < 2; ++a)
#pragma unroll
                for (int b = 0; b < 2; ++b)
#pragma unroll
                    for (int m = 0; m < 4; ++m)
#pragma unroll
                        for (int n = 0; n < 2; ++n) acc[a][b][m][n] = acc[a][b][m][n] * (1.0f / KREP);
        }
        E(acc, cur, wr, wc, fr, fq);
        if (!has_next) break;
#pragma unroll
        for (int a = 0; a < 2; ++a)
#pragma unroll
            for (int b = 0; b < 2; ++b)
#pragma unroll
                for (int m = 0; m < 4; ++m)
#pragma unroll
                    for (int n = 0; n < 2; ++n) acc[a][b][m][n] = (f32x4){0.f, 0.f, 0.f, 0.f};
        cur = nxt; cA = nA; cB = nB; ++ui;
        if (wr == 1) PG8_BAR;
    }
    PG8_WAIT_V(0);
    PG8_BAR;
#undef PG8_SA
#undef PG8_SB
#undef PG8_STAGE
#undef PG8_LDA
#undef PG8_LDB
#undef PG8_MMA
#undef PG8_WAIT_V
#undef PG8_WAIT_L
#undef PG8_BAR
#undef PG8_SCHED
}
}

__device__ __forceinline__ void wconv_item(const float* src, int ldsrc, const float* gain, bf16_t* dst, int lddst, LAS float* scr, int lane) {
    float wv[32];
#pragma unroll
    for (int i = 0; i < 32; ++i) { const int kk = 2 * i + (lane >> 5); wv[i] = src[(size_t)kk * ldsrc + (lane & 31)]; }
    if (gain) {
#pragma unroll
        for (int i = 0; i < 32; ++i) wv[i] *= gain[2 * i + (lane >> 5)]; }
#pragma unroll
    for (int i = 0; i < 32; ++i) { const int kk = 2 * i + (lane >> 5); scr[kk * 33 + (lane & 31)] = wv[i]; }
    LDS_WAIT(); asm volatile("" ::: "memory");
    const int c = lane & 7;
#pragma unroll
    for (int j = 0; j < 4; ++j) { const int n = (lane >> 3) + 8 * j; const LAS float* s = scr + (8 * c) * 33 + n;
        u32x4 o; o.x = cvt_pk_bf16(s[0 * 33], s[1 * 33]); o.y = cvt_pk_bf16(s[2 * 33], s[3 * 33]); o.z = cvt_pk_bf16(s[4 * 33], s[5 * 33]); o.w = cvt_pk_bf16(s[6 * 33], s[7 * 33]);
        *(u32x4*)(dst + (size_t)n * lddst + 8 * c) = o; }
    LDS_WAIT(); asm volatile("" ::: "memory");
}
__device__ __forceinline__ int win_src_col(int n0) {
    const int pn = n0 >> 8, rr = n0 & 255;
    if (pn < 4) return n0;
    const int q = (pn - 4) >> 3, j = (pn - 4) & 7, half = rr >> 7, off = rr & 127;
    int base;
    if (q == 0) base = half ? 4096 : 3072;
    else if (q == 1) base = half ? 5120 : 1024;
    else base = half ? 6144 : 2048;
    return base + 128 * j + off;
}


#define XB_TMO      128
#define XB_XCNT(j)  (256  + 64 * (j))
#define XB_XSUB(j)  (1280 + 64 * (j))
#define XB_XGEN(j)  (2304 + 64 * (j))
#define XB_TOP      3328
#define XB_TOPGEN   3392
#define XCD_BAR_WORDS 3456
#define XB_SPIN_CAP (1u << 18)
__device__ __forceinline__ unsigned xb_ld(unsigned* p)              { return __hip_atomic_load(p, __ATOMIC_RELAXED, __HIP_MEMORY_SCOPE_AGENT); }
__device__ __forceinline__ unsigned xb_add(unsigned* p, unsigned v) { return __hip_atomic_fetch_add(p, v, __ATOMIC_RELAXED, __HIP_MEMORY_SCOPE_AGENT); }
__device__ __forceinline__ unsigned xb_xcc_id() { return (unsigned)__builtin_amdgcn_s_getreg((3 << 11) | 20) & 0xFu; }
#define XB_SPIN(cond, bar) do { unsigned _sp = 0; while (cond) { __builtin_amdgcn_s_sleep(1); \
    if ((++_sp & 255u) == 0u) { if (xb_ld(&(bar)[XB_TMO])) break; if (_sp > XB_SPIN_CAP) { atomicAdd(&(bar)[XB_TMO], 1u); break; } } } } while (0)
struct XcdBarrier { unsigned* bar; unsigned x; volatile LAS unsigned* st; };
__device__ __forceinline__ XcdBarrier xcd_barrier_post(unsigned* bar, volatile LAS unsigned* st) {
    XcdBarrier b; b.bar = bar; b.x = xb_xcc_id(); b.st = st;
    if (threadIdx.x == 0) (void)xb_add(&bar[XB_XCNT(b.x)], 1u);
    return b;
}
__device__ __forceinline__ void xcd_barrier_complete(unsigned* bar, unsigned x, unsigned& nloc, unsigned& nx) {
    const unsigned G = gridDim.x * gridDim.y * gridDim.z;
    unsigned sum, cnt, mine, sp = 0u;
    for (;;) {
        sum = 0u; cnt = 0u; mine = 0u;
#pragma unroll
        for (unsigned j = 0; j < 16; ++j) { const unsigned c = xb_ld(&bar[XB_XCNT(j)]); sum += c; cnt += (c > 0u) ? 1u : 0u; mine = (j == x) ? c : mine; }
        if (sum == G) break;
        __builtin_amdgcn_s_sleep(1);
        if ((++sp & 255u) == 0u) { if (xb_ld(&bar[XB_TMO])) break; if (sp > XB_SPIN_CAP) { atomicAdd(&bar[XB_TMO], 1u); break; } }
    }
    nloc = mine > 0u ? mine : 1u; nx = cnt > 0u ? cnt : 1u;
}
__device__ __forceinline__ void xcd_barrier(const XcdBarrier& b, const bool local_only = false, const bool no_release = false) {
    asm volatile("s_waitcnt vmcnt(0)" ::: "memory");
    __syncthreads();
    if (threadIdx.x == 0) {
        unsigned* bar = b.bar;
        __builtin_amdgcn_s_waitcnt(0);
        unsigned nloc = b.st[0], nx = b.st[1];
        if (nloc == 0u) { xcd_barrier_complete(bar, b.x, nloc, nx); b.st[0] = nloc; b.st[1] = nx; }
        const unsigned old = xb_add(&bar[XB_XSUB(b.x)], 1u);
        const unsigned gen = old / nloc;
        if (old + 1u == (gen + 1u) * nloc) {
            if (!local_only) {
                if (!no_release) { __builtin_amdgcn_fence(__ATOMIC_RELEASE, "agent");
                                   asm volatile("s_waitcnt vmcnt(0)" ::: "memory"); }
                const unsigned og = xb_add(&bar[XB_TOP], 1u);
                const unsigned tg = og / nx;
                if (og + 1u == (tg + 1u) * nx) xb_add(&bar[XB_TOPGEN], 1u);
                else XB_SPIN(xb_ld(&bar[XB_TOPGEN]) == tg, bar);
            }
            __builtin_amdgcn_fence(__ATOMIC_ACQUIRE, "agent");
            xb_add(&bar[XB_XGEN(b.x)], 1u);
            asm volatile("s_waitcnt vmcnt(0)" ::: "memory");
        } else {
            XB_SPIN(xb_ld(&bar[XB_XGEN(b.x)]) == gen, bar);
            __builtin_amdgcn_fence(__ATOMIC_ACQUIRE, "agent");
            asm volatile("s_waitcnt vmcnt(0)" ::: "memory");
        }
    }
    __syncthreads();
}


struct Args { const float* in[20]; float* out; unsigned char* ws; int ph_lo, ph_hi; };

struct Ctx {
    const float* const* in; unsigned char* ws; float* X; LAS unsigned char* lds;
    int tid, lane, wave, gtid, NT, gw, NGW, G;
};

__device__ __forceinline__ void conv_early(const Ctx& c, int l) {
    LAS float* scr = (LAS float*)(c.lds + c.wave * 16384);
    bf16_t* WINT = (bf16_t*)(c.ws + WS_WIN); bf16_t* WGT = (bf16_t*)(c.ws + WS_WG);
    const float* w_in = c.in[3] + (size_t)l * DM * WIN; const float* g_mix = c.in[2] + l * DM;
    const float* wr_ = c.in[6] + (size_t)l * 262144; const float* wi_ = c.in[8] + (size_t)l * 262144;
    constexpr int I_WIN = 16 * 224, I_G = 4 * 64;
    for (int it = c.gw; it < I_WIN + I_G; it += c.NGW) {
        if (it < I_WIN) { const int kb = it / 224, nb = it % 224, k0 = 64 * kb, n0 = 32 * nb;
            wconv_item(w_in + (size_t)k0 * WIN + win_src_col(n0), WIN, g_mix + k0, WINT + (size_t)n0 * DM + k0, DM, scr, c.lane); }
        else { const int r = it - I_WIN, kb = r / 64, nb = r % 64, k0 = 64 * kb, n0 = 32 * nb;
            const int h = n0 >> 9, jt = (n0 >> 8) & 1, half = (n0 >> 7) & 1, off = n0 & 127;
            const float* src = (half ? wi_ : wr_) + (size_t)h * 65536 + (size_t)k0 * 256 + 128 * jt + off;
            wconv_item(src, 256, nullptr, WGT + (size_t)n0 * 256 + k0, 256, scr, c.lane); }
    }
}
__device__ __forceinline__ void conv_late(const Ctx& c, int l) {
    LAS float* scr = (LAS float*)(c.lds + c.wave * 16384);
    bf16_t* WOUT = (bf16_t*)(c.ws + WS_WOUT); bf16_t* WGU = (bf16_t*)(c.ws + WS_WGU); bf16_t* WDN = (bf16_t*)(c.ws + WS_WDN); bf16_t* WPG = (bf16_t*)(c.ws + WS_WPG); bf16_t* WPLE = (bf16_t*)(c.ws + WS_WPLE);
    const float* w_out = c.in[12] + (size_t)l * DM * DM; const float* g_ffn = c.in[13] + l * DM; const float* w_gu = c.in[14] + (size_t)l * DM * 2 * DFF;
    const float* w_dn = c.in[15] + (size_t)l * DFF * DM; const float* g_ple = c.in[16] + l * DM; const float* w_pg = c.in[17] + (size_t)l * DM * DM; const float* w_ple = c.in[18] + (size_t)l * PLE * DM;
    constexpr int I_O = 16 * 32, I_GU = 16 * 176, I_DN = 44 * 32, I_PG = 16 * 32, I_PL = 4 * 32;
    for (int it = c.gw; it < I_O + I_GU + I_DN + I_PG + I_PL; it += c.NGW) {
        int r = it;
        if (r < I_O) { const int kb = r / 32, nb = r % 32, k0 = 64 * kb, n0 = 32 * nb; wconv_item(w_out + (size_t)k0 * DM + n0, DM, nullptr, WOUT + (size_t)n0 * DM + k0, DM, scr, c.lane); continue; } r -= I_O;
        if (r < I_GU) { const int kb = r / 176, nb = r % 176, k0 = 64 * kb, n0 = 32 * nb; const int pn = n0 >> 8, half = (n0 >> 7) & 1, off = n0 & 127;
            wconv_item(w_gu + (size_t)k0 * (2 * DFF) + half * DFF + 128 * pn + off, 2 * DFF, g_ffn + k0, WGU + (size_t)n0 * DM + k0, DM, scr, c.lane); continue; } r -= I_GU;
        if (r < I_DN) { const int kb = r / 32, nb = r % 32, k0 = 64 * kb, n0 = 32 * nb; wconv_item(w_dn + (size_t)k0 * DM + n0, DM, nullptr, WDN + (size_t)n0 * DFF + k0, DFF, scr, c.lane); continue; } r -= I_DN;
        if (r < I_PG) { const int kb = r / 32, nb = r % 32, k0 = 64 * kb, n0 = 32 * nb; wconv_item(w_pg + (size_t)k0 * DM + n0, DM, g_ple + k0, WPG + (size_t)n0 * DM + k0, DM, scr, c.lane); continue; } r -= I_PG;
        { const int kb = r / 32, nb = r % 32, k0 = 64 * kb, n0 = 32 * nb; wconv_item(w_ple + (size_t)k0 * DM + n0, DM, nullptr, WPLE + (size_t)n0 * PLE + k0, PLE, scr, c.lane); }
    }
    const float* p = c.in[1] + (size_t)l * M * PLE; bf16_t* PB = (bf16_t*)(c.ws + WS_PB);
    for (int it0 = c.gtid; it0 < M * PLE / 8; it0 += 4 * c.NT) {
        f32x4 a[4], b[4];
#pragma unroll
        for (int q = 0; q < 4; ++q) { const int it = it0 + q * c.NT; if (it < M * PLE / 8) { a[q] = *(const f32x4*)(p + (size_t)it * 8); b[q] = *(const f32x4*)(p + (size_t)it * 8 + 4); } }
#pragma unroll
        for (int q = 0; q < 4; ++q) { const int it = it0 + q * c.NT; if (it < M * PLE / 8) {
            u32x4 w; w.x = cvt_pk_bf16(a[q].x, a[q].y); w.y = cvt_pk_bf16(a[q].z, a[q].w); w.z = cvt_pk_bf16(b[q].x, b[q].y); w.w = cvt_pk_bf16(b[q].z, b[q].w); *(u32x4*)(PB + (size_t)it * 8) = w; } }
    }
}

__device__ __forceinline__ float wave_sum(float v) {
#pragma unroll
    for (int o = 1; o < 64; o <<= 1) v += __shfl_xor(v, o);
    return v;
}

__device__ __forceinline__ void prologue(const Ctx& c) {
    const float* x = c.in[0]; bf16_t* XB = (bf16_t*)c.X; float* ssq1 = (float*)(c.ws + WS_SSQ1);
    for (int m0 = c.gw * 4; m0 < M; m0 += c.NGW * 4) {
        f32x4 v[4][4];
#pragma unroll
        for (int r = 0; r < 4; ++r) { const f32x4* xr = (const f32x4*)(x + (size_t)(m0 + r) * DM) + c.lane;
#pragma unroll
            for (int j = 0; j < 4; ++j) v[r][j] = xr[64 * j]; }
#pragma unroll
        for (int r = 0; r < 4; ++r) { const int m = m0 + r; float s = 0.f;
#pragma unroll
            for (int j = 0; j < 4; ++j) s += (v[r][j].x * v[r][j].x + v[r][j].y * v[r][j].y) + (v[r][j].z * v[r][j].z + v[r][j].w * v[r][j].w);
            s = wave_sum(s);
            u32x2* o = (u32x2*)(XB + (size_t)m * DM) + c.lane;
#pragma unroll
            for (int j = 0; j < 4; ++j) { u32x2 w; w.x = cvt_pk_bf16(v[r][j].x, v[r][j].y); w.y = cvt_pk_bf16(v[r][j].z, v[r][j].w); o[64 * j] = w; }
            if (c.lane < 16) ssq1[(size_t)m * 16 + c.lane] = (c.lane == 0) ? s : 0.f; }
    }
    float* sp8 = (float*)(c.ws + WS_SP8); const float* lam = c.in[10];
    for (int i = c.gtid; i < DEPTH * DM; i += c.NT) sp8[i] = 8.0f * log1pf(expf(-lam[i]));
    conv_early(c, 0);
}

__device__ __forceinline__ void conv4_phase(const Ctx& c, int l, unsigned vcu, bool xcd_local) {
    const bf16_t* RX = (const bf16_t*)(c.ws + WS_RX); bf16_t* XC = (bf16_t*)(c.ws + WS_XC);
    const float* w4 = c.in[4] + (size_t)l * 4 * DM; const float* b4 = c.in[5] + l * DM;
    const int nit = xcd_local ? 4 : ((M / 8) * 128 + c.NT - 1) / c.NT;
    for (int it_ = 0; it_ < nit; ++it_) {
        const int item = xcd_local ? (int)(vcu & 7u) * 65536 + (int)(vcu >> 3) * 512 + c.tid + 16384 * it_ : c.gtid + it_ * c.NT;
        if (item >= (M / 8) * 128) break;
        const int run = item >> 7, c0 = (item & 127) * 8, t0 = run * 8;
        float w[4][8], b[8];
#pragma unroll
        for (int k = 0; k < 4; ++k) { const f32x4 a = *(const f32x4*)(w4 + k * DM + c0), bb = *(const f32x4*)(w4 + k * DM + c0 + 4);
            w[k][0] = a.x; w[k][1] = a.y; w[k][2] = a.z; w[k][3] = a.w; w[k][4] = bb.x; w[k][5] = bb.y; w[k][6] = bb.z; w[k][7] = bb.w; }
        { const f32x4 a = *(const f32x4*)(b4 + c0), bb = *(const f32x4*)(b4 + c0 + 4); b[0] = a.x; b[1] = a.y; b[2] = a.z; b[3] = a.w; b[4] = bb.x; b[5] = bb.y; b[6] = bb.z; b[7] = bb.w; }
        float h0[8], h1[8], h2[8];
        if ((t0 & (SEQ - 1)) == 0) {
#pragma unroll
            for (int e = 0; e < 8; ++e) { h0[e] = 0.f; h1[e] = 0.f; h2[e] = 0.f; }
        } else {
            unpack8(*(const u32x4*)(RX + (size_t)(t0 - 3) * DM + c0), h0); unpack8(*(const u32x4*)(RX + (size_t)(t0 - 2) * DM + c0), h1); unpack8(*(const u32x4*)(RX + (size_t)(t0 - 1) * DM + c0), h2);
        }
        u32x4 wrow[8];
#pragma unroll
        for (int i = 0; i < 8; ++i) wrow[i] = *(const u32x4*)(RX + (size_t)(t0 + i) * DM + c0);
#pragma unroll
        for (int i = 0; i < 8; ++i) { float f[8], o[8]; unpack8(wrow[i], f);
#pragma unroll
            for (int e = 0; e < 8; ++e) { o[e] = b[e] + w[0][e] * h0[e] + w[1][e] * h1[e] + w[2][e] * h2[e] + w[3][e] * f[e]; h0[e] = h1[e]; h1[e] = h2[e]; h2[e] = f[e]; }
            *(u32x4*)(XC + (size_t)(t0 + i) * DM + c0) = pack8(o); }
    }
}

__device__ __forceinline__ void scan_local(const Ctx& c, int l) {
    bf16_t* PR = (bf16_t*)(c.ws + WS_RX); bf16_t* PI = (bf16_t*)(c.ws + WS_U); const bf16_t* XC = (const bf16_t*)(c.ws + WS_XC);
    float* PS = (float*)(c.ws + WS_PS); float* HS = (float*)(c.ws + WS_HS); const float* sp8 = (const float*)(c.ws + WS_SP8) + l * DM;
    for (int item = c.gtid; item < NCHUNK * 256; item += c.NT) {
        const int chunk = item >> 8, c0 = (item & 255) * 4;
        const f32x4 sp = *(const f32x4*)(sp8 + c0);
        f32x4 hl = (f32x4){0.f, 0.f, 0.f, 0.f}, cp = (f32x4){1.f, 1.f, 1.f, 1.f};
        const size_t base = (size_t)chunk * LCH * DM + c0;
        u32x2 nr_[8], ni_[8], nx_[8];
#pragma unroll
        for (int j = 0; j < 8; ++j) { const size_t o = base + (size_t)j * DM; nr_[j] = *(const u32x2*)(PR + o); ni_[j] = *(const u32x2*)(PI + o); nx_[j] = *(const u32x2*)(XC + o); }
#pragma unroll 1
        for (int tb = 0; tb < LCH; tb += 8) {
            u32x2 wr_[8], wi_[8], wx_[8];
#pragma unroll
            for (int j = 0; j < 8; ++j) { wr_[j] = nr_[j]; wi_[j] = ni_[j]; wx_[j] = nx_[j]; }
            if (tb + 8 < LCH) {
#pragma unroll
                for (int j = 0; j < 8; ++j) { const size_t o = base + (size_t)(tb + 8 + j) * DM; nr_[j] = *(const u32x2*)(PR + o); ni_[j] = *(const u32x2*)(PI + o); nx_[j] = *(const u32x2*)(XC + o); } }
#pragma unroll
            for (int j = 0; j < 8; ++j) {
                const f32x4 pr = unpack4v(wr_[j]), pi = unpack4v(wi_[j]), xc = unpack4v(wx_[j]);
                const f32x4 r = sigm4(pr), ig = sigm4(pi);
                const f32x4 lg = -(r * sp), x2 = lg + lg;
                f32x4 em = x2 * (x2 * (x2 * (x2 * (x2 * (x2 * 0.0013888889f + 0.0083333338f) + 0.041666668f) + 0.16666667f) + 0.5f) + 1.0f);
                if (__builtin_amdgcn_ballot_w64((x2.x <= -0.25f) | (x2.y <= -0.25f) | (x2.z <= -0.25f) | (x2.w <= -0.25f)) != 0ull) {
#pragma unroll
                    for (int e = 0; e < 4; ++e) if (x2[e] <= -0.25f) em[e] = __expf(x2[e]) - 1.f; }
                f32x4 s; s.x = __builtin_amdgcn_sqrtf(-em.x); s.y = __builtin_amdgcn_sqrtf(-em.y); s.z = __builtin_amdgcn_sqrtf(-em.z); s.w = __builtin_amdgcn_sqrtf(-em.w);
                const f32x4 a = exp2n4(-lg), uu = s * ig * xc;
                hl = a * hl + uu; cp = cp * a;
                const size_t o = base + (size_t)(tb + j) * DM;
                *(u32x2*)(PI + o) = pack4(hl); *(u32x2*)(PR + o) = pack4(cp); }
        }
        *(f32x4*)(PS + (size_t)chunk * DM + c0) = cp; *(f32x4*)(HS + (size_t)chunk * DM + c0) = hl;
    }
}
__device__ __forceinline__ void merge_phase(const Ctx& c, int l, unsigned bx) {
    const bf16_t* CP = (const bf16_t*)c.X + (size_t)M * DM; const bf16_t* HL = (const bf16_t*)(c.ws + WS_U); const bf16_t* CX = (const bf16_t*)(c.ws + WS_CX);
    const bf16_t* GY = (const bf16_t*)(c.ws + WS_GY); const bf16_t* GB = (const bf16_t*)(c.ws + WS_GB); bf16_t* MG = (bf16_t*)(c.ws + WS_XC);
    const float* PS = (const float*)(c.ws + WS_PS); const float* HS = (const float*)(c.ws + WS_HS); const float* w3 = c.in[11] + (size_t)l * 3 * DM;
    LAS float* carr = (LAS float*)c.lds;
    constexpr int CPS = SEQ / LCH;
    for (int rb = (int)bx; rb < M / 128; rb += c.G) {
        const int k0 = 2 * rb, kk0 = k0 % CPS, kbase = k0 - kk0;
        { const int c2 = 2 * c.tid; f32x2 carry = (f32x2){0.f, 0.f};
#pragma unroll 1
          for (int k = 0; k < kk0; k += 32) {
              f32x2 P[32], H[32];
#pragma unroll
              for (int j = 0; j < 32; ++j) { const int kc = (k + j < kk0) ? (k + j) : (kk0 - 1); P[j] = *(const f32x2*)(PS + (size_t)(kbase + kc) * DM + c2); H[j] = *(const f32x2*)(HS + (size_t)(kbase + kc) * DM + c2); }
#pragma unroll
              for (int j = 0; j < 32; ++j) { if (k + j < kk0) carry = P[j] * carry + H[j]; } }
          const f32x2 P = *(const f32x2*)(PS + (size_t)k0 * DM + c2), H = *(const f32x2*)(HS + (size_t)k0 * DM + c2);
          const f32x2 carry1 = P * carry + H;
          carr[c2] = carry.x; carr[c2 + 1] = carry.y; carr[DM + c2] = carry1.x; carr[DM + c2 + 1] = carry1.y; }
        __syncthreads();
#pragma unroll 1
        for (int it = 0; it < 4; ++it) {
            const int item = c.tid + 512 * it, run = item >> 7, c0 = (item & 127) * 8, t0 = rb * 128 + run * 8;
            float w[3][8], cr[8];
#pragma unroll
            for (int k = 0; k < 3; ++k) { const f32x4 a = *(const f32x4*)(w3 + k * DM + c0), bb = *(const f32x4*)(w3 + k * DM + c0 + 4);
                w[k][0] = a.x; w[k][1] = a.y; w[k][2] = a.z; w[k][3] = a.w; w[k][4] = bb.x; w[k][5] = bb.y; w[k][6] = bb.z; w[k][7] = bb.w; }
            { const LAS f32x4* cp4 = (const LAS f32x4*)(carr + (run >> 3) * DM + c0); const f32x4 a = cp4[0], bb = cp4[1]; cr[0] = a.x; cr[1] = a.y; cr[2] = a.z; cr[3] = a.w; cr[4] = bb.x; cr[5] = bb.y; cr[6] = bb.z; cr[7] = bb.w; }
            float p0[8], p1[8];
            if ((t0 & (SEQ - 1)) == 0) {
#pragma unroll
                for (int e = 0; e < 8; ++e) { p0[e] = 0.f; p1[e] = 0.f; }
            } else { unpack8(*(const u32x4*)(CX + (size_t)(t0 - 2) * DM + c0), p0); unpack8(*(const u32x4*)(CX + (size_t)(t0 - 1) * DM + c0), p1); }
#pragma unroll
            for (int ib = 0; ib < 8; ib += 4) {
                u32x4 whl[4], wcp[4], wgy[4], wgb[4], wcx[4];
#pragma unroll
                for (int i = 0; i < 4; ++i) { const size_t off = (size_t)(t0 + ib + i) * DM + c0;
                    whl[i] = *(const u32x4*)(HL + off); wcp[i] = *(const u32x4*)(CP + off); wgy[i] = *(const u32x4*)(GY + off); wgb[i] = *(const u32x4*)(GB + off); wcx[i] = *(const u32x4*)(CX + off); }
#pragma unroll
                for (int i = 0; i < 4; ++i) { const size_t off = (size_t)(t0 + ib + i) * DM + c0;
                    float hl[8], cp[8], gy[8], gb[8], cx[8], o[8];
                    unpack8(whl[i], hl); unpack8(wcp[i], cp); unpack8(wgy[i], gy); unpack8(wgb[i], gb); unpack8(wcx[i], cx);
#pragma unroll
                    for (int e = 0; e < 8; ++e) { const float h = hl[e] + cp[e] * cr[e]; o[e] = gy[e] * h + gb[e] * (w[0][e] * p0[e] + w[1][e] * p1[e] + w[2][e] * cx[e]); p0[e] = p1[e]; p1[e] = cx[e]; }
                    *(u32x4*)(MG + off) = pack8(o); }
            }
        }
        __syncthreads();
    }
}
__device__ __forceinline__ void final_phase(const Ctx& c) {
    const float* ssq = (const float*)(c.ws + WS_SSQ1); const float* g = c.in[19]; const bf16_t* xl = (const bf16_t*)(c.ws + WS_XC);
    f32x4 gv[4];
#pragma unroll
    for (int j = 0; j < 4; ++j) gv[j] = ((const f32x4*)g)[c.lane + 64 * j];
    for (int m0 = c.gw * 4; m0 < M; m0 += c.NGW * 4) {
        u32x2 xw[4][4]; float rs[4];
#pragma unroll
        for (int r = 0; r < 4; ++r) { const u32x2* xr = (const u32x2*)(xl + (size_t)(m0 + r) * DM) + c.lane; rs[r] = row_rstd(ssq, m0 + r);
#pragma unroll
            for (int j = 0; j < 4; ++j) xw[r][j] = xr[64 * j]; }
#pragma unroll
        for (int r = 0; r < 4; ++r) { f32x4* orow = (f32x4*)((float*)c.X + (size_t)(m0 + r) * DM) + c.lane;
#pragma unroll
            for (int j = 0; j < 4; ++j) orow[64 * j] = unpack4v(xw[r][j]) * rs[r] * gv[j]; }
    }
}

__global__ void __launch_bounds__(512, 2) fwd_mega(Args a) {
    extern __shared__ __attribute__((aligned(16))) unsigned char lds_raw[];
    cg::grid_group grid = cg::this_grid();
    volatile LAS unsigned* bst = (volatile LAS unsigned*)((LAS unsigned char*)lds_raw + RING_BYTES + 256);
    if (threadIdx.x < 8) bst[threadIdx.x] = 0u;
    __syncthreads();
    const XcdBarrier xbar = xcd_barrier_post((unsigned*)(a.ws + WS_BAR), bst);
    unsigned* xcnt = (unsigned*)(a.ws + WS_BAR) + 3584;
    if (threadIdx.x == 0) bst[4] = xb_add(&xcnt[64 * xbar.x], 1u);
    __syncthreads();
    const unsigned my_rank = (unsigned)__builtin_amdgcn_readfirstlane((int)bst[4]);
    unsigned vcu = blockIdx.x; bool vcu_known = false;
#ifndef LOCAL_SEAMS
#define LOCAL_SEAMS 1
#endif
#ifndef KREP_WIN
#define KREP_WIN 1
#endif
#ifndef DUPMASK
#define DUPMASK 0
#endif
#ifndef EXTRA_SYNCS
#define EXTRA_SYNCS 0
#endif
    bool dup_done = false;
    for (int ph = a.ph_lo; ph < a.ph_hi; ++ph) {
        if (!vcu_known && ph > a.ph_lo) {
            bool ok = (gridDim.x % 8u) == 0u;
            for (unsigned j = 0; j < 8; ++j) ok = ok && ((unsigned)__builtin_amdgcn_readfirstlane((int)xb_ld(&xcnt[64 * j])) == gridDim.x / 8u);
            if (ok && xbar.x < 8u && my_rank < gridDim.x / 8u) vcu = my_rank * 8u + xbar.x;
            if (threadIdx.x == 0) bst[5] = ok ? 1u : 0u;
            vcu_known = true;
        }
        int tid_ = threadIdx.x; unsigned bx_ = vcu; size_t zoff_ = 0;
        asm volatile("" : "+v"(tid_)); asm volatile("" : "+s"(bx_)); asm volatile("" : "+s"(zoff_));
        unsigned char* ws = a.ws + zoff_; float* outp = a.out + zoff_;
        Ctx c;
        c.in = a.in; c.ws = ws; c.X = outp; c.lds = (LAS unsigned char*)lds_raw;
        c.tid = tid_; c.lane = c.tid & 63; c.wave = __builtin_amdgcn_readfirstlane(c.tid >> 6);
        c.G = gridDim.x; c.gtid = bx_ * 512 + c.tid; c.NT = c.G * 512; c.gw = bx_ * 8 + c.wave; c.NGW = c.G * 8;
        bf16_t* XB = (bf16_t*)(ws + WS_XB);
        bf16_t* XBA = (bf16_t*)outp;
        float* ssq1 = (float*)(ws + WS_SSQ1); float* ssq2 = (float*)(ws + WS_SSQ2); float* ssq3 = (float*)(ws + WS_SSQ3);
        if (ph == 0) prologue(c);
        else if (ph == 1 + NSUB * DEPTH) final_phase(c);
        else {
            const int l = (ph - 1) / NSUB, s = (ph - 1) % NSUB;
            pg8::StaticOrder S;
            switch (s) {
#if !defined(ONLY) || ONLY == 0
            case 0: {
                pg8::Gemm g{XBA, (const bf16_t*)(ws + WS_WIN)}; S.init(M, WIN, c.G, bx_);
                pg8::EpiWin E{(bf16_t*)(ws + WS_RX), (bf16_t*)(ws + WS_CX), ssq1, (const LAS float*)(c.lds + SSQ_TAB_OFF)};
                pg8::gemm_phase<DM, DM, DM, 0, KREP_WIN>(c.lds, c.tid, g, S, E); } break;
#endif
#if !defined(ONLY) || ONLY == 1
            case 1: conv4_phase(c, l, bx_, LOCAL_SEAMS && bst[5] != 0u && c.G == 256); conv_late(c, l); break;
#endif
#if !defined(ONLY) || ONLY == 2
            case 2: {
                pg8::Gemm g{(const bf16_t*)(ws + WS_XC), (const bf16_t*)(ws + WS_WG)}; S.init(M, 2048, c.G, bx_);
                pg8::EpiGateScan E{(const bf16_t*)(ws + WS_XC), (bf16_t*)outp + (size_t)M * DM, (bf16_t*)(ws + WS_U), (float*)(ws + WS_PS), (float*)(ws + WS_HS), a.in[7] + l * DM, a.in[9] + l * DM, (const float*)(ws + WS_SP8) + l * DM};
                pg8::gemm_phase<256, DM, 256, 256>(c.lds, c.tid, g, S, E); } break;
#endif
#if !defined(ONLY) || ONLY == 5
            case 3: merge_phase(c, l, bx_); if (l + 1 < DEPTH) conv_early(c, l + 1); break;
#endif
#if !defined(ONLY) || ONLY == 6
            case 4: {
                { pg8::Gemm g{(const bf16_t*)(ws + WS_XC), (const bf16_t*)(ws + WS_WOUT)}; S.init(M, DM, c.G, bx_);
                  pg8::EpiRes E{XBA, XB, ssq2};
                  pg8::gemm_phase<DM, DM, DM, 0>(c.lds, c.tid, g, S, E); }
                { int tid2 = c.tid; asm volatile("" : "+v"(tid2));
                  pg8::Gemm g{(const bf16_t*)(ws + WS_PB), (const bf16_t*)(ws + WS_WPLE)}; S.init(M, DM, c.G, bx_);
                  pg8::EpiBf E{(bf16_t*)(ws + WS_U), DM};
                  pg8::gemm_phase<PLE, PLE, PLE, 0>(c.lds, tid2, g, S, E); } } break;
#endif
#if !defined(ONLY) || ONLY == 7
            case 5: {
                pg8::Gemm g{XB, (const bf16_t*)(ws + WS_WGU)}; S.init(M, 2 * DFF, c.G, bx_);
                pg8::EpiSwi E{(bf16_t*)(ws + WS_ACT), ssq2, (const LAS float*)(c.lds + SSQ_TAB_OFF)};
                pg8::gemm_phase<DM, DM, DM, 0>(c.lds, c.tid, g, S, E); } break;
#endif
#if !defined(ONLY) || ONLY == 8
            case 6: {
                pg8::Gemm g{(const bf16_t*)(ws + WS_ACT), (const bf16_t*)(ws + WS_WDN)}; S.init(M, DM, c.G, bx_);
                pg8::EpiRes E{XB, XB, ssq3};
                pg8::gemm_phase<DFF, DFF, DFF, 0>(c.lds, c.tid, g, S, E); } break;
#endif
#if !defined(ONLY) || ONLY == 9
            default: {
                pg8::Gemm g{XB, (const bf16_t*)(ws + WS_WPG)}; S.init(M, DM, c.G, bx_);
                pg8::EpiPle E{XB, (l == DEPTH - 1) ? (bf16_t*)(ws + WS_XC) : XBA, (const bf16_t*)(ws + WS_U), ssq3, ssq1, (const LAS float*)(c.lds + SSQ_TAB_OFF)};
                pg8::gemm_phase<DM, DM, DM, 0>(c.lds, c.tid, g, S, E); } break;
#endif
            }
        }
        if (ph + 1 < a.ph_hi) {
            const int s_ = (ph >= 1 && ph <= NSUB * DEPTH) ? (ph - 1) % NSUB : -1;
            if (a.ph_hi < 0) grid.sync();
            else xcd_barrier(xbar, LOCAL_SEAMS && (s_ == 4 || s_ == 5 || s_ == 6 || (s_ == 1 && gridDim.x == 256u)) && bst[5] != 0u,
                             LOCAL_SEAMS && s_ == 7 && ph < NSUB * DEPTH && bst[5] != 0u); }
        for (int xs = 0; xs < EXTRA_SYNCS; ++xs) xcd_barrier(xbar);
        if (DUPMASK != 0 && ph >= 1 && ph <= NSUB * DEPTH && ((DUPMASK >> ((ph - 1) % NSUB)) & 1) && !dup_done) { dup_done = true; --ph; } else dup_done = false;
    }
}

extern "C" void kernel_launch(void* const* d_in, const int* in_sizes, int n_in, void* d_out, int out_size, void* d_ws, size_t ws_size, hipStream_t stream) {
    static int grid = 0;
    if (grid == 0) {
        if (n_in != 20 || out_size != M * DM || ws_size < WS_END) { fprintf(stderr, "kernel_launch: unexpected sizes n_in %d out %d ws %zu\n", n_in, out_size, ws_size); grid = -1; return; }
        int dev = 0, cus = 0, per_cu = 0;
        hipGetDevice(&dev); hipDeviceGetAttribute(&cus, hipDeviceAttributeMultiprocessorCount, dev);
        if (hipFuncSetAttribute((const void*)fwd_mega, hipFuncAttributeMaxDynamicSharedMemorySize, LDS_BYTES) != hipSuccess) { fprintf(stderr, "kernel_launch: hipFuncSetAttribute failed\n"); grid = -1; return; }
        if (hipOccupancyMaxActiveBlocksPerMultiprocessor(&per_cu, (const void*)fwd_mega, 512, LDS_BYTES) != hipSuccess || per_cu < 1) { fprintf(stderr, "kernel_launch: occupancy query gives %d\n", per_cu); per_cu = 1; }
        (void)hipGetLastError();
        grid = cus * 1;
    }
    if (grid < 0) return;
    if (hipMemsetAsync((char*)d_ws + WS_BAR, 0, BAR_BYTES, stream) != hipSuccess) { fprintf(stderr, "kernel_launch: memset failed\n"); return; }
    Args a{};
    for (int i = 0; i < 20; ++i) a.in[i] = (const float*)d_in[i];
    a.out = (float*)d_out; a.ws = (unsigned char*)d_ws; a.ph_lo = 0; a.ph_hi = 2 + NSUB * DEPTH;
    void* args[] = {&a};
    hipError_t e = hipLaunchCooperativeKernel((const void*)fwd_mega, dim3(grid), dim3(512), args, LDS_BYTES, stream);
    if (e != hipSuccess) fprintf(stderr, "cooperative launch failed: %s (grid %d)\n", hipGetErrorString(e), grid);
}
```
